# Optimizing an MI355X kernel written in HIP

```python
import math
import jax
import jax.numpy as jnp
from jax import lax
import numpy as np

D_MODEL = 1024
BATCH = 4
SEQ = 4096
DEPTH = 4

GRID_W = 64
CTX_LEN = 256
N_MIXERS = 4
N_MOD = 9
D_FF = 2816
EPS = 1e-6
ROPE_BASE = 10000.0
ROPE_DIM = 64
Q_BLOCK = 128
NEG_INF = -1e30

MLA_HEADS = 8
MLA_Q_RANK = 512
MLA_KV_RANK = 256
MLA_NOPE = 128
MLA_ROPE = ROPE_DIM
MLA_V = 128

SWA_Q_HEADS = 16
SWA_KV_HEADS = 4
SWA_GROUP = SWA_Q_HEADS // SWA_KV_HEADS
SWA_HEAD_DIM = ROPE_DIM
SWA_WINDOW = 128

NA_HEADS = 16
NA_HEAD_DIM = D_MODEL // NA_HEADS
NA_KH = 8
NA_KW = 16

DIFF_HEADS = 8
DIFF_HEAD_DIM = ROPE_DIM

kernel_name = 'hybrid_mla_swa_na_diff_macaron_dit'


def rms_norm(x, g):
    xf = x.astype(jnp.float32)
    y = xf * lax.rsqrt(jnp.mean(xf * xf, axis=-1, keepdims=True) + EPS)
    return (y * g.astype(jnp.float32)).astype(x.dtype)


def modulate(h, shift, scale):
    return h * (1.0 + scale) + shift


def swiglu(h, w_in, w_out):
    g, u = jnp.split(h @ w_in, 2, axis=-1)
    return (jax.nn.silu(g) * u) @ w_out


def axial_rope_tables(L, dim):
    t = jnp.arange(L, dtype=jnp.int32)
    row = (t // GRID_W).astype(jnp.float32)
    col = (t % GRID_W).astype(jnp.float32)
    n_freq = dim // 4
    inv = jnp.exp(-math.log(ROPE_BASE) * jnp.arange(n_freq, dtype=jnp.float32) / n_freq)
    ang = jnp.concatenate([row[:, None] * inv, col[:, None] * inv], axis=-1)
    return jnp.cos(ang), jnp.sin(ang)


def apply_rope(x, cos, sin):
    half = x.shape[-1] // 2
    x1 = x[..., :half].astype(jnp.float32)
    x2 = x[..., half:].astype(jnp.float32)
    return jnp.concatenate([x1 * cos - x2 * sin, x1 * sin + x2 * cos], axis=-1).astype(x.dtype)


def softmax32(s):
    return jax.nn.softmax(s.astype(jnp.float32), axis=-1)


def joint_softmax(*scores):
    sizes = [s.shape[-1] for s in scores]
    p = softmax32(jnp.concatenate([s.astype(jnp.float32) for s in scores], axis=-1))
    cuts = [int(v) for v in np.cumsum(sizes)[:-1]]
    return jnp.split(p, cuts, axis=-1)


def to_blocks(t):
    lead = t.shape[:-2]
    L, d = t.shape[-2], t.shape[-1]
    t = t.reshape(lead + (L // Q_BLOCK, Q_BLOCK, d))
    return jnp.moveaxis(t, -3, 0)


def from_blocks(t):
    t = jnp.moveaxis(t, 0, -3)
    lead = t.shape[:-3]
    nb, qb, d = t.shape[-3], t.shape[-2], t.shape[-1]
    return t.reshape(lead + (nb * qb, d))


def merge_heads(o):
    B, H, N, d = o.shape
    return o.transpose(0, 2, 1, 3).reshape(B, N, H * d)


def pv(eq, p, v):
    return jnp.einsum(eq, p.astype(v.dtype), v)


def mla_mixer(hx, hc, w_down, q_norm, kv_norm, w_uq, w_ukv, w_o, cos, sin, ctx_out):
    H = MLA_HEADS
    scale = (MLA_NOPE + MLA_ROPE) ** -0.5

    def project(h):
        B, N, _ = h.shape
        d = h @ w_down
        cq = rms_norm(d[..., :MLA_Q_RANK], q_norm)
        ckv = rms_norm(d[..., MLA_Q_RANK:MLA_Q_RANK + MLA_KV_RANK], kv_norm)
        k_rope = d[..., MLA_Q_RANK + MLA_KV_RANK:]
        q = (cq @ w_uq).reshape(B, N, H, MLA_NOPE + MLA_ROPE).transpose(0, 2, 1, 3)
        kv = (ckv @ w_ukv).reshape(B, N, H, MLA_NOPE + MLA_V).transpose(0, 2, 1, 3)
        return q[..., :MLA_NOPE], q[..., MLA_NOPE:], kv[..., :MLA_NOPE], k_rope, kv[..., MLA_NOPE:]

    qn_x, qr_x, kn_x, kr_x, v_x = project(hx)
    qn_c, qr_c, kn_c, kr_c, v_c = project(hc)
    qr_x_rot = apply_rope(qr_x, cos, sin)
    kr_x_rot = apply_rope(kr_x, cos, sin)

    def scores(qn, qr, kn, kr):
        s = jnp.einsum('bhqd,bhkd->bhqk', qn, kn) + jnp.einsum('bhqr,bkr->bhqk', qr, kr)
        return s.astype(jnp.float32) * scale

    def block(args):
        qn, qr_rot, qr_pl = args
        p_x, p_c = joint_softmax(scores(qn, qr_rot, kn_x, kr_x_rot), scores(qn, qr_pl, kn_c, kr_c))
        return pv('bhqk,bhkd->bhqd', p_x, v_x) + pv('bhqk,bhkd->bhqd', p_c, v_c)

    o_x = from_blocks(lax.map(block, (to_blocks(qn_x), to_blocks(qr_x_rot), to_blocks(qr_x))))
    out_x = merge_heads(o_x) @ w_o
    out_c = None
    if ctx_out:
        p = softmax32(scores(qn_c, qr_c, kn_c, kr_c))
        out_c = merge_heads(pv('bhqk,bhkd->bhqd', p, v_c)) @ w_o
    return out_x, out_c


def swa_mixer(hx, hc, w_qkv, sink, w_o, cos, sin, ctx_out):
    Hk, G, Dh = SWA_KV_HEADS, SWA_GROUP, SWA_HEAD_DIM
    scale = Dh ** -0.5

    def project(h):
        B, N, _ = h.shape
        p = h @ w_qkv
        q = p[..., :Hk * G * Dh].reshape(B, N, Hk, G, Dh).transpose(0, 2, 3, 1, 4)
        k = p[..., Hk * G * Dh:(Hk * G + Hk) * Dh].reshape(B, N, Hk, Dh).transpose(0, 2, 1, 3)
        v = p[..., (Hk * G + Hk) * Dh:].reshape(B, N, Hk, Dh).transpose(0, 2, 1, 3)
        return q, k, v

    B, L, _ = hx.shape
    C = hc.shape[1]
    q_x, k_x, v_x = project(hx)
    q_c, k_c, v_c = project(hc)
    q_x_rot = apply_rope(q_x, cos, sin)
    k_x_rot = apply_rope(k_x, cos, sin)
    pad = ((0, 0), (0, 0), (SWA_WINDOW, SWA_WINDOW), (0, 0))
    k_pad = jnp.pad(k_x_rot, pad)
    v_pad = jnp.pad(v_x, pad)
    span = Q_BLOCK + 2 * SWA_WINDOW
    qi = jnp.arange(Q_BLOCK)
    kj = jnp.arange(span)
    sink_b = sink.reshape(Hk, G)[None, :, :, None, None].astype(jnp.float32)

    def ctx_scores(q):
        return jnp.einsum('bkgqd,bkcd->bkgqc', q, k_c).astype(jnp.float32) * scale

    def block(args):
        n, q_rot, q_pl = args
        start = n * Q_BLOCK
        k_b = lax.dynamic_slice_in_dim(k_pad, start, span, axis=2)
        v_b = lax.dynamic_slice_in_dim(v_pad, start, span, axis=2)
        qpos = start + qi
        kpos = start - SWA_WINDOW + kj
        valid = ((jnp.abs(kpos[None, :] - qpos[:, None]) <= SWA_WINDOW)
                 & (kpos[None, :] >= 0) & (kpos[None, :] < L))
        s_w = jnp.einsum('bkgqd,bkjd->bkgqj', q_rot, k_b).astype(jnp.float32) * scale
        s_w = jnp.where(valid, s_w, NEG_INF)
        s_c = ctx_scores(q_pl)
        s_s = jnp.broadcast_to(sink_b, s_c.shape[:-1] + (1,))
        p_w, p_c, _ = joint_softmax(s_w, s_c, s_s)
        return pv('bkgqj,bkjd->bkgqd', p_w, v_b) + pv('bkgqc,bkcd->bkgqd', p_c, v_c)

    nb = L // Q_BLOCK
    o = from_blocks(lax.map(block, (jnp.arange(nb), to_blocks(q_x_rot), to_blocks(q_x))))
    out_x = o.transpose(0, 3, 1, 2, 4).reshape(B, L, Hk * G * Dh) @ w_o
    out_c = None
    if ctx_out:
        s_c = ctx_scores(q_c)
        s_s = jnp.broadcast_to(sink_b, s_c.shape[:-1] + (1,))
        p_c, _ = joint_softmax(s_c, s_s)
        o_c = pv('bkgqc,bkcd->bkgqd', p_c, v_c)
        out_c = o_c.transpose(0, 3, 1, 2, 4).reshape(B, C, Hk * G * Dh) @ w_o
    return out_x, out_c


def na_mixer(hx, hc, w_qkv, rpb, w_o, ctx_out):
    H, Dh = NA_HEADS, NA_HEAD_DIM
    scale = Dh ** -0.5

    def project(h):
        B, N, _ = h.shape
        p = (h @ w_qkv).reshape(B, N, 3, H, Dh).transpose(2, 0, 3, 1, 4)
        return p[0], p[1], p[2]

    B, L, _ = hx.shape
    rows = L // GRID_W
    kh = min(NA_KH, rows)
    kw = NA_KW
    q_x, k_x, v_x = project(hx)
    q_c, k_c, v_c = project(hc)
    col = jnp.arange(GRID_W)
    col_start = jnp.clip(col - kw // 2, 0, GRID_W - kw)
    key_cols = col_start[:, None] + jnp.arange(kw)[None, :]
    col_off = key_cols - col[:, None] + (NA_KW - 1)

    def block(args):
        r, q_row = args
        row_start = jnp.clip(r - kh // 2, 0, rows - kh)
        key_rows = row_start + jnp.arange(kh)
        idx = (key_rows[None, :, None] * GRID_W + key_cols[:, None, :]).reshape(-1)
        k_g = jnp.take(k_x, idx, axis=2).reshape(B, H, GRID_W, kh * kw, Dh)
        v_g = jnp.take(v_x, idx, axis=2).reshape(B, H, GRID_W, kh * kw, Dh)
        row_off = key_rows - r + (NA_KH - 1)
        bias = rpb[:, row_off[None, :, None], col_off[:, None, :]]
        bias = bias.reshape(H, GRID_W, kh * kw).astype(jnp.float32)
        s_n = jnp.einsum('bhqd,bhqkd->bhqk', q_row, k_g).astype(jnp.float32) * scale + bias[None]
        s_c = jnp.einsum('bhqd,bhcd->bhqc', q_row, k_c).astype(jnp.float32) * scale
        p_n, p_c = joint_softmax(s_n, s_c)
        return pv('bhqk,bhqkd->bhqd', p_n, v_g) + pv('bhqc,bhcd->bhqd', p_c, v_c)

    q_rows = q_x.reshape(B, H, rows, GRID_W, Dh).transpose(2, 0, 1, 3, 4)
    o = lax.map(block, (jnp.arange(rows), q_rows))
    out_x = o.transpose(1, 0, 3, 2, 4).reshape(B, L, H * Dh) @ w_o
    out_c = None
    if ctx_out:
        p = softmax32(jnp.einsum('bhqd,bhcd->bhqc', q_c, k_c).astype(jnp.float32) * scale)
        out_c = merge_heads(pv('bhqc,bhcd->bhqd', p, v_c)) @ w_o
    return out_x, out_c


def diff_mixer(hx, hc, w_qkv, lam_params, norm_g, w_o, cos, sin, lam_init, ctx_out):
    H, Dh = DIFF_HEADS, DIFF_HEAD_DIM
    scale = Dh ** -0.5

    def project(h):
        B, N, _ = h.shape
        p = h @ w_qkv
        q = p[..., :H * 2 * Dh].reshape(B, N, H, 2, Dh).transpose(0, 2, 3, 1, 4)
        k = p[..., H * 2 * Dh:H * 4 * Dh].reshape(B, N, H, 2, Dh).transpose(0, 2, 3, 1, 4)
        v = p[..., H * 4 * Dh:].reshape(B, N, H, 2 * Dh).transpose(0, 2, 1, 3)
        return q, k, v

    q_x, k_x, v_x = project(hx)
    q_c, k_c, v_c = project(hc)
    q_x_rot = apply_rope(q_x, cos, sin)
    k_x_rot = apply_rope(k_x, cos, sin)
    lp = lam_params.astype(jnp.float32)
    lam = jnp.exp(jnp.sum(lp[0] * lp[1])) - jnp.exp(jnp.sum(lp[2] * lp[3])) + lam_init

    def scores(q, k):
        return jnp.einsum('bhiqd,bhikd->bhiqk', q, k).astype(jnp.float32) * scale

    def block(args):
        q_rot, q_pl = args
        p_x, p_c = joint_softmax(scores(q_rot, k_x_rot), scores(q_pl, k_c))
        a_x = p_x[:, :, 0] - lam * p_x[:, :, 1]
        a_c = p_c[:, :, 0] - lam * p_c[:, :, 1]
        return pv('bhqk,bhkd->bhqd', a_x, v_x) + pv('bhqk,bhkd->bhqd', a_c, v_c)

    def finish(o):
        return merge_heads(rms_norm(o, norm_g) * (1.0 - lam_init)) @ w_o

    o_x = from_blocks(lax.map(block, (to_blocks(q_x_rot), to_blocks(q_x))))
    out_x = finish(o_x)
    out_c = None
    if ctx_out:
        p = softmax32(scores(q_c, k_c))
        out_c = finish(pv('bhqk,bhkd->bhqd', p[:, :, 0] - lam * p[:, :, 1], v_c))
    return out_x, out_c


def setup_inputs(seed: int = 0) -> dict:
    key = jax.random.key(seed)
    keys = jax.random.split(key, 32)
    counter = [0]

    def normal(shape, std):
        k = keys[counter[0]]
        counter[0] += 1
        return jax.random.normal(k, shape, jnp.float32) * std

    def gain(shape):
        return 1.0 + normal(shape, 0.02)

    nA, nB, nC, nD = [len(range(m, DEPTH, N_MIXERS)) for m in range(N_MIXERS)]
    D = D_MODEL
    return {
        'x': normal((BATCH, SEQ, D), 1.0),
        'c': normal((BATCH, D), 1.0),
        'ctx': normal((BATCH, CTX_LEN, D), 1.0),
        'c_ctx': normal((D,), 1.0),
        'mod_w': normal((DEPTH, D, N_MOD * D), 0.5 * D ** -0.5),
        'mod_b': normal((DEPTH, N_MOD * D), 0.02),
        'norm_g': gain((DEPTH, 3, D)),
        'final_norm_g': gain((D,)),
        'ffn_w_in': normal((DEPTH, 2, D, 2 * D_FF), D ** -0.5),
        'ffn_w_out': normal((DEPTH, 2, D_FF, D), D_FF ** -0.5),
        'mla_w_down': normal((nA, D, MLA_Q_RANK + MLA_KV_RANK + MLA_ROPE), D ** -0.5),
        'mla_q_norm': gain((nA, MLA_Q_RANK)),
        'mla_kv_norm': gain((nA, MLA_KV_RANK)),
        'mla_w_uq': normal((nA, MLA_Q_RANK, MLA_HEADS * (MLA_NOPE + MLA_ROPE)), MLA_Q_RANK ** -0.5),
        'mla_w_ukv': normal((nA, MLA_KV_RANK, MLA_HEADS * (MLA_NOPE + MLA_V)), MLA_KV_RANK ** -0.5),
        'mla_w_o': normal((nA, MLA_HEADS * MLA_V, D), (MLA_HEADS * MLA_V) ** -0.5),
        'swa_w_qkv': normal((nB, D, (SWA_Q_HEADS + 2 * SWA_KV_HEADS) * SWA_HEAD_DIM), D ** -0.5),
        'swa_sink': normal((nB, SWA_Q_HEADS), 0.5),
        'swa_w_o': normal((nB, SWA_Q_HEADS * SWA_HEAD_DIM, D), (SWA_Q_HEADS * SWA_HEAD_DIM) ** -0.5),
        'na_w_qkv': normal((nC, D, 3 * NA_HEADS * NA_HEAD_DIM), D ** -0.5),
        'na_rpb': normal((nC, NA_HEADS, 2 * NA_KH - 1, 2 * NA_KW - 1), 0.2),
        'na_w_o': normal((nC, NA_HEADS * NA_HEAD_DIM, D), (NA_HEADS * NA_HEAD_DIM) ** -0.5),
        'diff_w_qkv': normal((nD, D, 6 * DIFF_HEADS * DIFF_HEAD_DIM), D ** -0.5),
        'diff_lambda': normal((nD, 4, DIFF_HEAD_DIM), 0.1),
        'diff_norm_g': gain((nD, 2 * DIFF_HEAD_DIM)),
        'diff_w_o': normal((nD, 2 * DIFF_HEADS * DIFF_HEAD_DIM, D), (2 * DIFF_HEADS * DIFF_HEAD_DIM) ** -0.5),
    }


def reference(x, c, ctx, c_ctx, mod_w, mod_b, norm_g, final_norm_g, ffn_w_in, ffn_w_out,
              mla_w_down, mla_q_norm, mla_kv_norm, mla_w_uq, mla_w_ukv, mla_w_o,
              swa_w_qkv, swa_sink, swa_w_o, na_w_qkv, na_rpb, na_w_o,
              diff_w_qkv, diff_lambda, diff_norm_g, diff_w_o):
    L = x.shape[1]
    cos, sin = axial_rope_tables(L, ROPE_DIM)
    xc = ctx
    cond_x = jax.nn.silu(c)
    cond_c = jax.nn.silu(c_ctx)
    for layer in range(DEPTH):
        kind = layer % N_MIXERS
        j = layer // N_MIXERS
        last = layer == DEPTH - 1
        mx = jnp.split((cond_x @ mod_w[layer] + mod_b[layer])[:, None, :], N_MOD, axis=-1)
        mc = jnp.split(cond_c @ mod_w[layer] + mod_b[layer], N_MOD, axis=-1)

        x = x + 0.5 * mx[2] * swiglu(modulate(rms_norm(x, norm_g[layer, 0]), mx[0], mx[1]),
                                     ffn_w_in[layer, 0], ffn_w_out[layer, 0])
        xc = xc + 0.5 * mc[2] * swiglu(modulate(rms_norm(xc, norm_g[layer, 0]), mc[0], mc[1]),
                                       ffn_w_in[layer, 0], ffn_w_out[layer, 0])

        hx = modulate(rms_norm(x, norm_g[layer, 1]), mx[3], mx[4])
        hc = modulate(rms_norm(xc, norm_g[layer, 1]), mc[3], mc[4])
        if kind == 0:
            ox, oc = mla_mixer(hx, hc, mla_w_down[j], mla_q_norm[j], mla_kv_norm[j], mla_w_uq[j],
                               mla_w_ukv[j], mla_w_o[j], cos, sin, not last)
        elif kind == 1:
            ox, oc = swa_mixer(hx, hc, swa_w_qkv[j], swa_sink[j], swa_w_o[j], cos, sin, not last)
        elif kind == 2:
            ox, oc = na_mixer(hx, hc, na_w_qkv[j], na_rpb[j], na_w_o[j], not last)
        else:
            lam_init = 0.8 - 0.6 * math.exp(-0.3 * layer)
            ox, oc = diff_mixer(hx, hc, diff_w_qkv[j], diff_lambda[j], diff_norm_g[j], diff_w_o[j],
                                cos, sin, lam_init, not last)
        x = x + mx[5] * ox

        x = x + 0.5 * mx[8] * swiglu(modulate(rms_norm(x, norm_g[layer, 2]), mx[6], mx[7]),
                                     ffn_w_in[layer, 1], ffn_w_out[layer, 1])
        if not last:
            xc = xc + mc[5] * oc
            xc = xc + 0.5 * mc[8] * swiglu(modulate(rms_norm(xc, norm_g[layer, 2]), mc[6], mc[7]),
                                           ffn_w_in[layer, 1], ffn_w_out[layer, 1])
    return rms_norm(x, final_norm_g)
```

```cpp
#include <hip/hip_runtime.h>
#include <hip/hip_cooperative_groups.h>
#include <cstdio>
#include <cstdint>
namespace cg = cooperative_groups;

#ifndef MK_SINGLE
#define MK_SINGLE 1
#endif
#define PROBE_DUP 0

typedef unsigned short bf16_t;
typedef short bf16x8 __attribute__((ext_vector_type(8)));
typedef short s16x4 __attribute__((ext_vector_type(4)));
typedef float f32x4 __attribute__((ext_vector_type(4)));
typedef float f32x2 __attribute__((ext_vector_type(2)));
typedef float f32x16 __attribute__((ext_vector_type(16)));
typedef unsigned u32x4 __attribute__((ext_vector_type(4)));
typedef unsigned u32x2 __attribute__((ext_vector_type(2)));
typedef __bf16 bf2_t __attribute__((ext_vector_type(2)));
#define DI __device__ __forceinline__

constexpr int MT = 17408;
constexpr int NLAT = 16384;
constexpr int DM = 1024;
constexpr int DFF = 2816;
constexpr int NTHREADS = 512;
constexpr int LDS_BYTES = 131072 + 16;
constexpr float EPSV = 1e-6f;
constexpr float LOG2E = 1.4426950408889634f;

constexpr size_t al256(size_t x) { return (x + 255) & ~(size_t)255; }
constexpr size_t OFF_BAR = 0;
constexpr size_t OFF_MODS = 16384;
constexpr size_t OFF_COS = al256(OFF_MODS + (size_t)4 * 5 * 9216 * 4);
constexpr size_t OFF_SIN = al256(OFF_COS + (size_t)4096 * 32 * 4);
constexpr size_t OFF_STATS = al256(OFF_SIN + (size_t)4096 * 32 * 4);
constexpr size_t OFF_X = al256(OFF_STATS + (size_t)MT * 16 * 4);
constexpr size_t OFF_H = al256(OFF_X + (size_t)MT * 1024 * 4);
constexpr size_t OFF_W = al256(OFF_H + (size_t)MT * 1024 * 2);
constexpr size_t W_IN = 0;
constexpr size_t W_OUT = W_IN + (size_t)8 * 5632 * 1024;
constexpr size_t W_MLA_DOWN = W_OUT + (size_t)8 * 1024 * 2816;
constexpr size_t W_MLA_UQ = W_MLA_DOWN + (size_t)1024 * 1024;
constexpr size_t W_MLA_UK = W_MLA_UQ + (size_t)1536 * 512;
constexpr size_t W_MLA_UV = W_MLA_UK + (size_t)1024 * 256;
constexpr size_t W_MLA_WO = W_MLA_UV + (size_t)1024 * 256;
constexpr size_t W_SWA_QK = W_MLA_WO + (size_t)1024 * 1024;
constexpr size_t W_SWA_V = W_SWA_QK + (size_t)1280 * 1024;
constexpr size_t W_SWA_WO = W_SWA_V + (size_t)256 * 1024;
constexpr size_t W_NA_QK = W_SWA_WO + (size_t)1024 * 1024;
constexpr size_t W_NA_V = W_NA_QK + (size_t)2048 * 1024;
constexpr size_t W_NA_WO = W_NA_V + (size_t)1024 * 1024;
constexpr size_t W_DIFF_QK = W_NA_WO + (size_t)1024 * 1024;
constexpr size_t W_DIFF_V = W_DIFF_QK + (size_t)2048 * 1024;
constexpr size_t W_DIFF_WO = W_DIFF_V + (size_t)1024 * 1024;
constexpr size_t W_TOTAL = W_DIFF_WO + (size_t)1024 * 1024;
constexpr size_t OFF_R = al256(OFF_W + W_TOTAL * 2);
constexpr size_t R_Q = 0;
constexpr size_t R_K = al256(R_Q + (size_t)MT * 2048 * 2);
constexpr size_t R_VT = al256(R_K + (size_t)MT * 1536 * 2);
constexpr size_t R_DRAW = al256(R_VT + (size_t)1024 * MT * 2);
constexpr size_t R_END = al256(R_DRAW + (size_t)MT * 1024 * 2);
constexpr size_t WS_NEED = OFF_R + R_END;

struct Params {
    const float* in[26];
    float* out;
    char* ws;
};

DI unsigned pack2(float lo, float hi) {
    f32x2 v = {lo, hi};
    bf2_t b = __builtin_convertvector(v, bf2_t);
    return __builtin_bit_cast(unsigned, b);
}
DI u32x2 pack4(f32x4 v) { u32x2 r; r.x = pack2(v[0], v[1]); r.y = pack2(v[2], v[3]); return r; }
DI float fexp2(float x) { return __builtin_amdgcn_exp2f(x); }
DI float siluf(float g) { return g * __builtin_amdgcn_rcpf(1.0f + __builtin_amdgcn_exp2f(-g * LOG2E)); }
DI int mod_row(int row) { return row < NLAT ? (row >> 12) : 4; }
template <int M> DI float swz_xor(float x) { return __int_as_float(__builtin_amdgcn_ds_swizzle(__float_as_int(x), (M << 10) | 0x1f)); }
DI float bperm(float x, int addr) { return __int_as_float(__builtin_amdgcn_ds_bpermute(addr, __float_as_int(x))); }
DI float wave_sum(float x, int lane) {
    x += bperm(x, (lane ^ 32) << 2);
    x += swz_xor<16>(x); x += swz_xor<8>(x); x += swz_xor<4>(x); x += swz_xor<2>(x); x += swz_xor<1>(x);
    return x;
}
DI int fresh_tid(int wave_s) {
    int lane;
    asm volatile("v_mbcnt_lo_u32_b32 %0, -1, 0\n\tv_mbcnt_hi_u32_b32 %0, -1, %0" : "=v"(lane));
    return wave_s * 64 + lane;
}


#define XB_TMO      128
#define XB_XCNT(j)  (256  + 64 * (j))
#define XB_XSUB(j)  (1280 + 64 * (j))
#define XB_XGEN(j)  (2304 + 64 * (j))
#define XB_TOP      3328
#define XB_TOPGEN   3392
#define XCD_BAR_WORDS 3456
#define XB_SPIN_CAP (1u << 18)
#define LAS __attribute__((address_space(3)))
DI unsigned xb_ld(unsigned* p) { return __hip_atomic_load(p, __ATOMIC_RELAXED, __HIP_MEMORY_SCOPE_AGENT); }
DI unsigned xb_add(unsigned* p, unsigned v) { return __hip_atomic_fetch_add(p, v, __ATOMIC_RELAXED, __HIP_MEMORY_SCOPE_AGENT); }
DI unsigned xb_xcc_id() { return (unsigned)__builtin_amdgcn_s_getreg((3 << 11) | 20) & 0xFu; }
#define XB_SPIN(cond, bar) do { unsigned _sp = 0; while (cond) { __builtin_amdgcn_s_sleep(1); \
    if ((++_sp & 255u) == 0u) { if (xb_ld(&(bar)[XB_TMO])) break; if (_sp > XB_SPIN_CAP) { atomicAdd(&(bar)[XB_TMO], 1u); break; } } } } while (0)
struct XcdBarrier { unsigned* bar; unsigned x; volatile LAS unsigned* st; };
DI void xcd_barrier_complete(unsigned* bar, unsigned x, unsigned& nloc, unsigned& nx) {
    const unsigned G = gridDim.x * gridDim.y * gridDim.z;
    unsigned sum, cnt, mine, sp = 0u;
    for (;;) {
        sum = 0u; cnt = 0u; mine = 0u;
#pragma unroll
        for (unsigned j = 0; j < 16; ++j) { const unsigned c = xb_ld(&bar[XB_XCNT(j)]); sum += c; cnt += (c > 0u) ? 1u : 0u; mine = (j == x) ? c : mine; }
        if (sum == G) break;
        __builtin_amdgcn_s_sleep(1);
        if ((++sp & 255u) == 0u) { if (xb_ld(&bar[XB_TMO])) break; if (sp > XB_SPIN_CAP) { atomicAdd(&bar[XB_TMO], 1u); break; } }
    }
    nloc = mine > 0u ? mine : 1u; nx = cnt > 0u ? cnt : 1u;
}
DI void xcd_barrier(const XcdBarrier& b, const bool leader_thread) {
    asm volatile("s_waitcnt vmcnt(0)" ::: "memory");
    __syncthreads();
    if (leader_thread) {
        unsigned* bar = b.bar;
        __builtin_amdgcn_s_waitcnt(0);
        unsigned nloc = b.st[0], nx = b.st[1];
        if (nloc == 0u) { xcd_barrier_complete(bar, b.x, nloc, nx); b.st[0] = nloc; b.st[1] = nx; }
        const unsigned old = xb_add(&bar[XB_XSUB(b.x)], 1u);
        const unsigned gen = old / nloc;
        if (old + 1u == (gen + 1u) * nloc) {
            __builtin_amdgcn_fence(__ATOMIC_RELEASE, "agent");
            asm volatile("s_waitcnt vmcnt(0)" ::: "memory");
            const unsigned og = xb_add(&bar[XB_TOP], 1u);
            const unsigned tg = og / nx;
            if (og + 1u == (tg + 1u) * nx) xb_add(&bar[XB_TOPGEN], 1u);
            else XB_SPIN(xb_ld(&bar[XB_TOPGEN]) == tg, bar);
            __builtin_amdgcn_fence(__ATOMIC_ACQUIRE, "agent");
            xb_add(&bar[XB_XGEN(b.x)], 1u);
            asm volatile("s_waitcnt vmcnt(0)" ::: "memory");
        } else {
            XB_SPIN(xb_ld(&bar[XB_XGEN(b.x)]) == gen, bar);
            __builtin_amdgcn_fence(__ATOMIC_ACQUIRE, "agent");
            asm volatile("s_waitcnt vmcnt(0)" ::: "memory");
        }
    }
    __syncthreads();
}

constexpr int BM = 256, BK = 64, HALF = 128, HT = HALF * BK;
DI int lds_byte(int r, int c) {
    int st = (r >> 4) * 2 + (c >> 5), rr = r & 15, cc = c & 31, ob = rr * 64 + cc * 2;
    return st * 1024 + (ob ^ (((ob >> 9) & 1) << 5));
}
DI void stage_rc(int b, int& R, int& C) {
    int st = b / 1024, sb = b % 1024, swz = sb ^ (((sb >> 9) & 1) << 5);
    R = (st >> 1) * 16 + swz / 64; C = (st & 1) * 32 + (swz % 64) / 2;
}

enum { EPI_RESID = 0, EPI_RESID_ATOMIC, EPI_SWIGLU, EPI_PLAIN2, EPI_ROPE, EPI_MLA_DOWN, EPI_MLA_Q, EPI_MLA_K, EPI_VT };

struct GemmJob {
    const bf16_t* A; const bf16_t* B; int lda, ldb, M, N, K, epi;
    void* o0; void* o1; float* o2; const float* f0; const float* f1; int i0; float s0; int ksplit, row0;
};

DI void gemm_epilogue(const GemmJob& J, f32x4 (&acc)[2][2][4][2], int brow, int bcol, int wr, int wc, int fr, int fq, int ks) {
    const int epi = J.epi;
    if (epi == EPI_RESID) {
        const float* gp = J.f0 + (size_t)mod_row(brow) * 9216;
        const float cf = J.s0;
        f32x4 gv[2][2];
#pragma unroll
        for (int bj = 0; bj < 2; ++bj)
#pragma unroll
            for (int n = 0; n < 2; ++n) gv[bj][n] = *(const f32x4*)(gp + bcol + bj * HALF + wc * 32 + fq * 8 + n * 4) * cf;
#pragma unroll
        for (int ai = 0; ai < 2; ++ai) {
            f32x4 xv[4][2][2];
#pragma unroll
            for (int m = 0; m < 4; ++m) {
                const float* xp = (const float*)J.o0 + (size_t)(brow + ai * HALF + wr * 64 + m * 16 + fr) * DM + bcol + wc * 32 + fq * 8;
#pragma unroll
                for (int bj = 0; bj < 2; ++bj)
#pragma unroll
                    for (int n = 0; n < 2; ++n) xv[m][bj][n] = *(const f32x4*)(xp + bj * HALF + n * 4);
            }
            __builtin_amdgcn_sched_barrier(0);
#pragma unroll
            for (int m = 0; m < 4; ++m) {
                float* xp = (float*)J.o0 + (size_t)(brow + ai * HALF + wr * 64 + m * 16 + fr) * DM + bcol + wc * 32 + fq * 8;
#pragma unroll
                for (int bj = 0; bj < 2; ++bj)
#pragma unroll
                    for (int n = 0; n < 2; ++n) *(f32x4*)(xp + bj * HALF + n * 4) = xv[m][bj][n] + gv[bj][n] * acc[ai][bj][m][n];
            }
            __builtin_amdgcn_sched_barrier(0);
        }
        return;
    }
#pragma unroll
    for (int ai = 0; ai < 2; ++ai)
#pragma unroll
        for (int m = 0; m < 4; ++m) {
            const int row = brow + ai * HALF + wr * 64 + m * 16 + fr;
            if (epi == EPI_RESID) {
                const float* gp = J.f0 + (size_t)mod_row(row) * 9216;
                float* xp = (float*)J.o0 + (size_t)row * DM;
                const float cf = J.s0;
#pragma unroll
                for (int bj = 0; bj < 2; ++bj)
#pragma unroll
                    for (int n = 0; n < 2; ++n) {
                        const int col = bcol + bj * HALF + wc * 32 + n * 16 + fq * 4;
                        f32x4 g = *(const f32x4*)(gp + col);
                        f32x4 x = *(const f32x4*)(xp + col);
                        x += (g * cf) * acc[ai][bj][m][n];
                        *(f32x4*)(xp + col) = x;
                    }
            } else if (epi == EPI_RESID_ATOMIC) {
                const float* gp = J.f0 + (size_t)mod_row(row) * 9216;
                float* pp = J.o2 + ((size_t)ks * (MT - NLAT) + (row - NLAT)) * DM;
                const float cf = J.s0;
#pragma unroll
                for (int bj = 0; bj < 2; ++bj)
#pragma unroll
                    for (int n = 0; n < 2; ++n) {
                        const int col = bcol + bj * HALF + wc * 32 + fq * 8 + n * 4;
                        f32x4 g = *(const f32x4*)(gp + col);
                        *(f32x4*)(pp + col) = (g * cf) * acc[ai][bj][m][n];
                    }
            } else if (epi == EPI_SWIGLU) {
                bf16_t* op = (bf16_t*)J.o0 + (size_t)row * DFF + (bcol >> 1) + wc * 32 + fq * 8;
                f32x4 o0, o1;
#pragma unroll
                for (int j = 0; j < 4; ++j) { o0[j] = siluf(acc[ai][0][m][0][j]) * acc[ai][1][m][0][j]; o1[j] = siluf(acc[ai][0][m][1][j]) * acc[ai][1][m][1][j]; }
                u32x4 w; { const u32x2 a = pack4(o0), b = pack4(o1); w.x = a.x; w.y = a.y; w.z = b.x; w.w = b.y; }
                *(u32x4*)op = w;
            } else if (epi == EPI_PLAIN2) {
                bf16_t* q = (bf16_t*)J.o0 + (size_t)row * 1024;
                bf16_t* k = (bf16_t*)J.o1 + (size_t)row * 1024;
#pragma unroll
                for (int bj = 0; bj < 2; ++bj)
#pragma unroll
                    for (int n = 0; n < 2; ++n) {
                        const int col = bcol + bj * HALF + wc * 32 + n * 16 + fq * 4;
                        bf16_t* d = col < 1024 ? q + col : k + (col - 1024);
                        *(u32x2*)d = pack4(acc[ai][bj][m][n]);
                    }
            } else if (epi == EPI_ROPE) {
                const int NQH = J.i0, NKH = (J.N >> 6) - NQH;
                const bool latent = row < NLAT;
                const int pos = row & 4095;
#pragma unroll
                for (int bj = 0; bj < 2; ++bj) {
                    const int gcol = bcol + bj * HALF + wc * 32;
                    const int head64 = gcol >> 6, di = ((gcol >> 5) & 1) * 16 + fq * 4;
                    f32x4 v0 = acc[ai][bj][m][0], v1 = acc[ai][bj][m][1], r1 = v0, r2 = v1;
                    if (latent) {
                        f32x4 c4 = *(const f32x4*)(J.f0 + pos * 32 + di), s4 = *(const f32x4*)(J.f1 + pos * 32 + di);
                        r1 = v0 * c4 - v1 * s4; r2 = v0 * s4 + v1 * c4;
                    }
                    if (head64 < NQH) {
                        bf16_t* q = (bf16_t*)J.o0 + (size_t)row * (NQH * 128) + head64 * 128;
                        *(u32x2*)(q + 64 + di) = pack4(v0); *(u32x2*)(q + 96 + di) = pack4(v1);
                        *(u32x2*)(q + di) = pack4(r1); *(u32x2*)(q + 32 + di) = pack4(r2);
                    } else {
                        bf16_t* k = (bf16_t*)J.o1 + (size_t)row * (NKH * 64) + (head64 - NQH) * 64;
                        *(u32x2*)(k + di) = pack4(r1); *(u32x2*)(k + 32 + di) = pack4(r2);
                    }
                }
            } else if (epi == EPI_MLA_DOWN) {
                const int pn = bcol >> 8;
                if (pn < 3) {
                    bf16_t* d = (bf16_t*)J.o0 + (size_t)row * 1024;
                    float ss = 0.f;
#pragma unroll
                    for (int bj = 0; bj < 2; ++bj)
#pragma unroll
                        for (int n = 0; n < 2; ++n) {
                            const int col = bcol + bj * HALF + wc * 32 + n * 16 + fq * 4;
                            f32x4 v = acc[ai][bj][m][n];
                            ss += v[0] * v[0] + v[1] * v[1] + v[2] * v[2] + v[3] * v[3];
                            *(u32x2*)(d + col) = pack4(v);
                        }
                    ss += swz_xor<16>(ss); ss += bperm(ss, ((fq * 16 + fr) ^ 32) << 2);
                    if (fq == 0) J.o2[(size_t)row * 16 + pn * 4 + wc] = ss;
                } else if (wc < 2) {
                    const bool latent = row < NLAT;
                    const int pos = row & 4095, di = wc * 16 + fq * 4;
                    f32x4 v0 = acc[ai][0][m][0], v1 = acc[ai][0][m][1], r1 = v0, r2 = v1;
                    if (latent) {
                        f32x4 c4 = *(const f32x4*)(J.f0 + pos * 32 + di), s4 = *(const f32x4*)(J.f1 + pos * 32 + di);
                        r1 = v0 * c4 - v1 * s4; r2 = v0 * s4 + v1 * c4;
                    }
                    u32x2 p1 = pack4(r1), p2 = pack4(r2);
                    bf16_t* k = (bf16_t*)J.o1 + (size_t)row * 1536 + 128 + di;
#pragma unroll
                    for (int hh = 0; hh < 8; ++hh) { *(u32x2*)(k + hh * 192) = p1; *(u32x2*)(k + hh * 192 + 32) = p2; }
                }
            } else if (epi == EPI_MLA_Q) {
                const float* sp = J.f0 + (size_t)row * 16;
                f32x4 a = *(const f32x4*)sp, b = *(const f32x4*)(sp + 4);
                const float rstd = rsqrtf((a[0] + a[1] + a[2] + a[3] + b[0] + b[1] + b[2] + b[3]) * (1.0f / 512.0f) + EPSV);
                const bool latent = row < NLAT;
                const int pos = row & 4095;
                const float* cosT = (const float*)J.o1; const float* sinT = J.f1;
#pragma unroll
                for (int bj = 0; bj < 2; ++bj) {
                    const int g = (bcol + bj * HALF + wc * 32) >> 5;
                    const int head = g / 6, gi = g - head * 6;
                    bf16_t* q = (bf16_t*)J.o0 + (size_t)row * 2048 + head * 256;
                    f32x4 v0 = acc[ai][bj][m][0] * rstd, v1 = acc[ai][bj][m][1] * rstd;
                    if (gi < 4) {
                        *(u32x2*)(q + gi * 32 + fq * 4) = pack4(v0); *(u32x2*)(q + gi * 32 + 16 + fq * 4) = pack4(v1);
                    } else {
                        const int di = (gi - 4) * 16 + fq * 4;
                        *(u32x2*)(q + 192 + di) = pack4(v0); *(u32x2*)(q + 224 + di) = pack4(v1);
                        if (latent) {
                            f32x4 c4 = *(const f32x4*)(cosT + pos * 32 + di), s4 = *(const f32x4*)(sinT + pos * 32 + di);
                            *(u32x2*)(q + 128 + di) = pack4(v0 * c4 - v1 * s4); *(u32x2*)(q + 160 + di) = pack4(v0 * s4 + v1 * c4);
                        }
                    }
                }
            } else if (epi == EPI_MLA_K) {
                f32x4 a = *(const f32x4*)(J.f0 + (size_t)row * 16 + 8);
                const float rstd = rsqrtf((a[0] + a[1] + a[2] + a[3]) * (1.0f / 256.0f) + EPSV);
                bf16_t* k = (bf16_t*)J.o0 + (size_t)row * 1536;
#pragma unroll
                for (int bj = 0; bj < 2; ++bj)
#pragma unroll
                    for (int n = 0; n < 2; ++n) {
                        const int col = bcol + bj * HALF + wc * 32 + n * 16 + fq * 4;
                        *(u32x2*)(k + (col >> 7) * 192 + (col & 127)) = pack4(acc[ai][bj][m][n] * rstd);
                    }
            } else {
                bf16_t* vt = (bf16_t*)J.o0 + (size_t)row * MT;
#pragma unroll
                for (int bj = 0; bj < 2; ++bj)
#pragma unroll
                    for (int n = 0; n < 2; ++n) {
                        const int col = bcol + bj * HALF + wc * 32 + n * 16 + fq * 4;
                        f32x4 v = acc[ai][bj][m][n];
                        if (J.i0) {
#pragma unroll
                            for (int j = 0; j < 4; ++j) {
                                f32x4 a = *(const f32x4*)(J.f0 + (size_t)(col + j) * 16 + 8);
                                v[j] *= rsqrtf((a[0] + a[1] + a[2] + a[3]) * (1.0f / 256.0f) + EPSV);
                            }
                        }
                        *(u32x2*)(vt + col) = pack4(v);
                    }
            }
            __builtin_amdgcn_sched_barrier(0);
        }
}

DI void gemm_run(const GemmJob& J, char* lds, const int tid_in, const int rot) {
    bf16_t* shm = (bf16_t*)lds;
    const int lda = J.lda, ldb = J.ldb, ksplit = J.ksplit;
    const __amdgpu_buffer_rsrc_t rs_A = __builtin_amdgcn_make_buffer_rsrc((void*)J.A, 0, 0x7fffffff, 0x00020000);
    const __amdgpu_buffer_rsrc_t rs_Bt = __builtin_amdgcn_make_buffer_rsrc((void*)J.B, 0, 0x7fffffff, 0x00020000);
#define SA(b, h) (shm + ((b) * 2 + (h)) * HT)
#define SB(b, h) (shm + (4 + (b) * 2 + (h)) * HT)
#define STAGE(P, BASE, OFF, LD, br, kt) do { const int _so = ((br) * (LD) + (kt) * BK) * 2 + kbyte; \
    for (int _i = 0; _i < 2; ++_i) { \
      __builtin_amdgcn_raw_ptr_buffer_load_lds(rs_##BASE, \
        (__attribute__((address_space(3))) unsigned*)((char*)(P) + tid_in * 1024 + _i * 8192), 16, OFF[_i], _so, 0, 0); } } while (0)
#define LDA(dst, b, h) for (int m = 0; m < 4; ++m) for (int k = 0; k < 2; ++k) \
    dst[m][k] = *reinterpret_cast<const bf16x8*>((char*)SA(b, h) + lds_byte(wr * 64 + m * 16 + fr, k * 32 + fq * 8))
#define LDB(dst, b, h) for (int n = 0; n < 2; ++n) for (int k = 0; k < 2; ++k) \
    dst[n][k] = *reinterpret_cast<const bf16x8*>((char*)SB(b, h) + lds_byte(wc * 32 + n * 16 + fr, k * 32 + fq * 8))
#define MMA(ai, bj, At_, Bt_) do { __builtin_amdgcn_s_setprio(1); \
    for (int m = 0; m < 4; ++m) for (int n = 0; n < 2; ++n) for (int k = 0; k < 2; ++k) \
      acc[ai][bj][m][n] = __builtin_amdgcn_mfma_f32_16x16x32_bf16(Bt_[n][k], At_[m][k], acc[ai][bj][m][n], 0, 0, 0); \
    __builtin_amdgcn_s_setprio(0); } while (0)
#define WAIT_V(n) asm volatile("s_waitcnt vmcnt(" #n ")" ::: "memory")
#define WAIT_L(n) asm volatile("s_waitcnt lgkmcnt(" #n ")" ::: "memory")
#define BAR __builtin_amdgcn_s_barrier()
#define SCHED __builtin_amdgcn_sched_barrier(0)
    const int nM = J.M / BM, nN = J.N / BM, nwg = nM * nN * J.ksplit;
    const int nt = J.K / J.ksplit / BK;
    for (int it = 0;; ++it) {
        int cshift = (int)blockIdx.x - rot; if (cshift < 0) cshift += gridDim.x;
        const long L = (long)it * gridDim.x + cshift;
        if (L >= nwg) break;
        const int tid = fresh_tid(tid_in);
        const int wid = tid >> 6, lane = tid & 63, wr = wid >> 2, wc = wid & 3, fr = lane & 15, fq = lane >> 4;
        unsigned offA[2], offB[2];
#pragma unroll
        for (int i = 0; i < 2; ++i) { int r_, c_; stage_rc(tid * 16 + i * 8192, r_, c_); offA[i] = (unsigned)(r_ * lda + c_) * 2u; offB[i] = (unsigned)(r_ * ldb + c_) * 2u; }
        int pm, pn, kbyte = 0, ksel = 0;
        if (ksplit > 1) {
            const int tile = (int)L / ksplit, ks = (int)L % ksplit; ksel = ks;
            pm = tile % nM; pn = tile / nM;
            kbyte = ks * (J.K / ksplit) * 2;
        } else {
            int wgid = (int)L;
            { const int q = nwg / 8, r = nwg % 8, xcd = wgid % 8, off = wgid / 8; wgid = (xcd < r ? xcd * (q + 1) : r * (q + 1) + (xcd - r) * q) + off; }
            const int nig = 8 * nN, gid = wgid / nig, fm = gid * 8, gsz = (nM - fm) < 8 ? (nM - fm) : 8;
            pm = fm + ((wgid % nig) % gsz); pn = (wgid % nig) / gsz;
        }
        const int brow = pm * BM, bcol = pn * BM;
        f32x4 acc[2][2][4][2];
#pragma unroll
        for (int a = 0; a < 2; ++a)
#pragma unroll
            for (int b = 0; b < 2; ++b)
#pragma unroll
                for (int m = 0; m < 4; ++m)
#pragma unroll
                    for (int n = 0; n < 2; ++n) acc[a][b][m][n] = (f32x4){0.f, 0.f, 0.f, 0.f};
        bf16x8 At[4][2], B0[2][2], B1[2][2];
        WAIT_V(0);
        STAGE(SB(0, 0), Bt, offB, ldb, bcol, 0); STAGE(SA(0, 0), A, offA, lda, brow, 0);
        STAGE(SB(0, 1), Bt, offB, ldb, bcol + HALF, 0); STAGE(SA(0, 1), A, offA, lda, brow + HALF, 0);
        if (wr == 1) BAR;
        WAIT_V(4); BAR;
        STAGE(SB(1, 0), Bt, offB, ldb, bcol, 1); STAGE(SA(1, 0), A, offA, lda, brow, 1); STAGE(SB(1, 1), Bt, offB, ldb, bcol + HALF, 1);
        WAIT_V(6); BAR;
        for (int t = 0; t < nt - 2; t += 2) {
            LDB(B0, 0, 0); SCHED; LDA(At, 0, 0); STAGE(SA(1, 1), A, offA, lda, brow + HALF, t + 1);
            WAIT_L(8); BAR; WAIT_L(0); MMA(0, 0, At, B0); BAR; SCHED;
            LDB(B1, 0, 1); STAGE(SB(0, 0), Bt, offB, ldb, bcol, t + 2);
            BAR; WAIT_L(0); MMA(0, 1, At, B1); BAR;
            LDA(At, 0, 1); STAGE(SA(0, 0), A, offA, lda, brow, t + 2);
            BAR; WAIT_L(0); MMA(1, 0, At, B0); BAR; SCHED;
            STAGE(SB(0, 1), Bt, offB, ldb, bcol + HALF, t + 2);
            WAIT_V(6); BAR; MMA(1, 1, At, B1); BAR;
            LDB(B0, 1, 0); SCHED; LDA(At, 1, 0); STAGE(SA(0, 1), A, offA, lda, brow + HALF, t + 2);
            WAIT_L(8); BAR; WAIT_L(0); MMA(0, 0, At, B0); BAR; SCHED;
            LDB(B1, 1, 1); STAGE(SB(1, 0), Bt, offB, ldb, bcol, t + 3);
            BAR; WAIT_L(0); MMA(0, 1, At, B1); BAR;
            LDA(At, 1, 1); STAGE(SA(1, 0), A, offA, lda, brow, t + 3);
            BAR; WAIT_L(0); MMA(1, 0, At, B0); BAR; SCHED;
            STAGE(SB(1, 1), Bt, offB, ldb, bcol + HALF, t + 3);
            WAIT_V(6); BAR; MMA(1, 1, At, B1); BAR;
        }
        { LDB(B0, 0, 0); LDA(At, 0, 0); STAGE(SA(1, 1), A, offA, lda, brow + HALF, nt - 1);
          BAR; WAIT_L(0); MMA(0, 0, At, B0); BAR;
          LDB(B1, 0, 1); BAR; WAIT_L(0); MMA(0, 1, At, B1); BAR;
          LDA(At, 0, 1); WAIT_V(4); BAR; WAIT_L(0); MMA(1, 0, At, B0); MMA(1, 1, At, B1); BAR; }
        { LDB(B0, 1, 0); LDA(At, 1, 0); WAIT_V(2); BAR; WAIT_L(0); MMA(0, 0, At, B0); BAR;
          LDB(B1, 1, 1); WAIT_V(0); BAR; WAIT_L(0); MMA(0, 1, At, B1); BAR;
          LDA(At, 1, 1); BAR; WAIT_L(0); MMA(1, 0, At, B0); MMA(1, 1, At, B1); BAR; }
        if (wr == 0) BAR;
        { const int tid2 = fresh_tid(tid_in);
          const int wid2 = tid2 >> 6, lane2 = tid2 & 63;
          gemm_epilogue(J, acc, brow + J.row0, bcol, wid2 >> 2, wid2 & 3, lane2 & 15, lane2 >> 4, ksel); }
    }
#undef SA
#undef SB
}

struct AttnArgs {
    const bf16_t* q; int q_ts, q_hs, q_rot, q_plain;
    const bf16_t* k; int k_ts, k_hs;
    const bf16_t* vt; bf16_t* ao;
    int NH; int ctx_units; float scale;
    const float* sink; const float* rpb; const float* lamp; const float* ng; float lam_init;
};

DI int crow(int i, int h) { return (i & 3) + 8 * (i >> 2) + 4 * h; }

template <int DQK, int DV, int MODE, bool PAIR>
DI void attn_phase(const AttnArgs& a, char* lds, const int tid) {
    constexpr int KW = PAIR ? 128 : DQK;
    constexpr int KST = KW * 2 + 16;
    constexpr int VST = 136;
    constexpr int KBYTES = 64 * KST, VBYTES = DV * VST, BUF = KBYTES + VBYTES;
    constexpr int QB = PAIR ? 128 : 256;
    constexpr int NQB = 4096 / QB;
    constexpr int NS = DQK / 16, NDB = DV / 32;
    constexpr int KCH = (64 * KW * 2 / 16) / NTHREADS;
    constexpr int VCH = (DV * 128 / 16) / NTHREADS;
    constexpr int NOPE = DQK - 64;
    static_assert(2 * BUF <= 120 * 1024, "lds");
    const int wave = tid >> 6, lane = tid & 63, r = lane & 31, h = lane >> 5;
    const int x32 = (lane ^ 32) << 2;
    const int wq = PAIR ? (wave & 3) : wave, gsel = PAIR ? (wave >> 2) : 0;
    const int koff = gsel * 64;
    const float cs = a.scale * LOG2E;
    float* rpbL = (float*)(lds + 122880);
    const int n_lat = 4 * a.NH * NQB;
    const int n_units = n_lat + (a.ctx_units ? 4 * a.NH : 0);
    float lam = 0.f;
    if (PAIR) {
        float p0 = a.lamp[lane] * a.lamp[64 + lane], p1 = a.lamp[128 + lane] * a.lamp[192 + lane];
        p0 = wave_sum(p0, lane); p1 = wave_sum(p1, lane);
        lam = __expf(p0) - __expf(p1) + a.lam_init;
        lam = __int_as_float(__builtin_amdgcn_readfirstlane(__float_as_int(lam)));
    }
    for (int u = blockIdx.x; u < n_units; u += gridDim.x) {
        const bool isctx = u >= n_lat;
        int b, hh, qb;
        if (!isctx) { qb = u % NQB; hh = (u / NQB) % a.NH; b = u / (NQB * a.NH); }
        else { const int v = u - n_lat; qb = 0; hh = v % a.NH; b = v / a.NH; }
        const int tokq0 = isctx ? (NLAT + b * 256) : (b * 4096 + qb * QB);
        const int tokq = tokq0 + wq * 32 + r;
        const int qhead = PAIR ? 2 * hh + gsel : hh;
        const int kvhead = (MODE == 1) ? (hh >> 2) : hh;
        const bf16_t* qp = a.q + (size_t)tokq * a.q_ts + qhead * a.q_hs;
        const bf16_t* kbase = a.k + kvhead * a.k_hs;
        const bf16_t* vbase = a.vt + (size_t)(kvhead * DV) * MT;
        int tlo = 0, thi = 0;
        if (!isctx) {
            if (MODE == 0) { tlo = 0; thi = 64; }
            else if (MODE == 1) { const int q0 = qb * QB; tlo = (q0 - 128) < 0 ? 0 : (q0 - 128) >> 6; thi = (q0 + QB + 128) >> 6; if (thi > 64) thi = 64; }
            else { const int r0 = qb * 4; int lo = r0 - 4; lo = lo < 0 ? 0 : (lo > 56 ? 56 : lo); int hi2 = r0 + 3 - 4; hi2 = hi2 < 0 ? 0 : (hi2 > 56 ? 56 : hi2); tlo = lo; thi = hi2 + 8; }
        }
        const int T = 4 + (thi - tlo);
        if (MODE == 2) {
            for (int i = tid; i < 465; i += NTHREADS) rpbL[i] = a.rpb[hh * 465 + i];
        }
        const int qpos = qb * QB + wq * 32 + r;
        const int qrow = qpos >> 6, qcol = qpos & 63;
        int cstart = qcol - 8; cstart = cstart < 0 ? 0 : (cstart > 48 ? 48 : cstart);
        int rstart = qrow - 4; rstart = rstart < 0 ? 0 : (rstart > 56 ? 56 : rstart);

        constexpr bool D2 = (KCH + VCH) <= 4;
        constexpr int NSET = D2 ? 2 : 1;
        u32x4 kreg[NSET][KCH], vreg[NSET][VCH];
        const __amdgpu_buffer_rsrc_t rs_k = __builtin_amdgcn_make_buffer_rsrc((void*)kbase, 0, 0x7fffffff, 0x00020000);
        const __amdgpu_buffer_rsrc_t rs_v = __builtin_amdgcn_make_buffer_rsrc((void*)vbase, 0, 0x7fffffff, 0x00020000);
        auto tile_tok = [&](int t) { return t < 4 ? (NLAT + b * 256 + t * 64) : (b * 4096 + (tlo + t - 4) * 64); };
        auto load_tile = [&](int t, const int set) __attribute__((always_inline)) {
            const int tok = tile_tok(t);
#pragma unroll
            for (int c = 0; c < KCH; ++c) { const int idx = tid + c * NTHREADS, row = idx / (KW / 8), ch = idx % (KW / 8);
                kreg[set][c] = __builtin_amdgcn_raw_buffer_load_b128(rs_k, (row * a.k_ts + ch * 8) * 2, tok * a.k_ts * 2, 0); }
#pragma unroll
            for (int c = 0; c < VCH; ++c) { const int idx = tid + c * NTHREADS, row = idx >> 3, ch = idx & 7;
                vreg[set][c] = __builtin_amdgcn_raw_buffer_load_b128(rs_v, (row * MT + ch * 8) * 2, tok * 2, 0); }
        };
        auto store_tile = [&](int buf, const int set) __attribute__((always_inline)) {
            char* kb = lds + buf * BUF; char* vb = kb + KBYTES;
#pragma unroll
            for (int c = 0; c < KCH; ++c) { const int idx = tid + c * NTHREADS, row = idx / (KW / 8), ch = idx % (KW / 8);
                *(u32x4*)(kb + row * KST + ch * 16) = kreg[set][c]; }
#pragma unroll
            for (int c = 0; c < VCH; ++c) { const int idx = tid + c * NTHREADS, row = idx >> 3, ch = idx & 7;
                u32x2 w0 = {vreg[set][c].x, vreg[set][c].y}, w1 = {vreg[set][c].z, vreg[set][c].w};
                *(u32x2*)(vb + row * VST + ch * 16) = w0; *(u32x2*)(vb + row * VST + ch * 16 + 8) = w1; }
        };
        bf16x8 qf[NS];
        auto load_q = [&](bool lat) {
#pragma unroll
            for (int s = 0; s < NS; ++s) {
                const int off = (s * 16 < NOPE) ? s * 16 : ((lat ? a.q_rot : a.q_plain) + s * 16 - NOPE);
                qf[s] = *(const bf16x8*)(qp + off + 8 * h);
            }
        };
        f32x16 ot[NDB];
#pragma unroll
        for (int d = 0; d < NDB; ++d)
#pragma unroll
            for (int i = 0; i < 16; ++i) ot[d][i] = 0.f;
        float m_run = -1e30f, l_run = 0.f;

        if constexpr (PAIR) {
            static_assert(!PAIR || 3 * BUF <= 120 * 1024, "lds ring");
            auto s_block = [&](const char* kt_l, const int kb, f32x16& stv) __attribute__((always_inline)) {
                bf16x8 kf[NS];
#pragma unroll
                for (int s = 0; s < NS; ++s) kf[s] = *(const bf16x8*)(kt_l + (32 * kb + r) * KST + (koff + 8 * h) * 2 + s * 32);
#pragma unroll
                for (int i = 0; i < 16; ++i) stv[i] = 0.f;
#pragma unroll
                for (int s = 0; s < NS; ++s) stv = __builtin_amdgcn_mfma_f32_32x32x16_bf16(kf[s], qf[s], stv, 0, 0, 0);
            };
            auto sm_pv = [&](f32x16& stv, const char* vt_l, const int kb) __attribute__((always_inline)) {
                s16x4 vlo[NDB], vhi[NDB];
#pragma unroll
                for (int d = 0; d < NDB; ++d) {
                    const char* vp = vt_l + (32 * d + r) * VST + (32 * kb + 4 * h) * 2;
                    vlo[d] = *(const s16x4*)vp; vhi[d] = *(const s16x4*)(vp + 16);
                }
                float mx = -3e38f;
#pragma unroll
                for (int i = 0; i < 16; ++i) mx = fmaxf(mx, stv[i]);
                mx *= cs;
                mx = fmaxf(mx, bperm(mx, x32));
                const float m_new = fmaxf(m_run, mx);
                if (__any(m_new > m_run)) {
                    const float alpha = fexp2(m_run - m_new);
                    l_run *= alpha;
#pragma unroll
                    for (int d = 0; d < NDB; ++d)
#pragma unroll
                        for (int i = 0; i < 16; ++i) ot[d][i] *= alpha;
                }
                m_run = m_new;
                float rs = 0.f;
#pragma unroll
                for (int i = 0; i < 16; ++i) { const float p = fexp2(__builtin_fmaf(stv[i], cs, -m_new)); stv[i] = p; rs += p; }
                l_run += rs;
#pragma unroll
                for (int s2 = 0; s2 < 2; ++s2) {
                    u32x4 pw;
                    pw.x = pack2(stv[8 * s2 + 0], stv[8 * s2 + 1]); pw.y = pack2(stv[8 * s2 + 2], stv[8 * s2 + 3]);
                    pw.z = pack2(stv[8 * s2 + 4], stv[8 * s2 + 5]); pw.w = pack2(stv[8 * s2 + 6], stv[8 * s2 + 7]);
                    const bf16x8 pf = __builtin_bit_cast(bf16x8, pw);
#pragma unroll
                    for (int d = 0; d < NDB; ++d) {
                        const bf16x8 vf = __builtin_shufflevector(vlo[d], vhi[d], 0, 1, 2, 3, 4, 5, 6, 7);
                        ot[d] = __builtin_amdgcn_mfma_f32_32x32x16_bf16(vf, pf, ot[d], 0, 0, 0);
                    }
                    if (s2 == 0) {
#pragma unroll
                        for (int d = 0; d < NDB; ++d) {
                            const char* vp = vt_l + (32 * d + r) * VST + (32 * kb + 16 + 4 * h) * 2;
                            vlo[d] = *(const s16x4*)vp; vhi[d] = *(const s16x4*)(vp + 16);
                        }
                    }
                }
            };
            load_tile(0, 0); store_tile(0, 0);
            load_tile(1, 1); store_tile(1, 1);
            load_q(false);
            __syncthreads();
            load_tile(2, 0);
            f32x16 st_cur, st_n;
            s_block(lds, 0, st_cur);
            auto pbody = [&](const int t, const int PAR, const bool RELOAD) __attribute__((always_inline)) {
                load_tile(t + 3 < T ? t + 3 : T - 1, PAR ^ 1);
                const char* kt_l = lds + (t % 3) * BUF;
                const char* vt_l = kt_l + KBYTES;
                s_block(kt_l, 1, st_n);
                sm_pv(st_cur, vt_l, 0);
#pragma unroll
                for (int i = 0; i < 16; ++i) st_cur[i] = st_n[i];
                if (RELOAD) load_q(true);
                s_block(lds + ((t + 1) % 3) * BUF, 0, st_n);
                sm_pv(st_cur, vt_l, 1);
#pragma unroll
                for (int i = 0; i < 16; ++i) st_cur[i] = st_n[i];
                store_tile((t + 2) % 3, PAR);
                __syncthreads();
            };
            pbody(0, 0, false); pbody(1, 1, false); pbody(2, 0, false); pbody(3, 1, true);
            for (int t = 4; t < T; t += 2) { pbody(t, 0, false); pbody(t + 1, 1, false); }
        } else {
        load_tile(0, 0); store_tile(0, 0);
        if (D2) load_tile(T > 1 ? 1 : 0, 1);
        load_q(false);
        __syncthreads();
        auto tile_body = [&](const int t, const bool LAT, const int PAR) __attribute__((always_inline)) {
            if (D2) load_tile(t + 2 < T ? t + 2 : T - 1, PAR);
            else load_tile(t + 1 < T ? t + 1 : T - 1, 0);
            const char* kb_l = lds + (t & 1) * BUF; const char* vb_l = kb_l + KBYTES;
            bool skip = false;
            const int kt = tlo + t - 4;
            if (LAT) {
                if (MODE == 1) { const int ts = kt * 64, qw = qb * QB + wq * 32; skip = (ts + 63 < qw - 128) || (ts > qw + 31 + 128); }
                if (MODE == 2) { skip = (kt < rstart) || (kt >= rstart + 8); }
            }
            if (!skip) {
              if constexpr (DQK == 64) {
                constexpr int G = (NS <= 4) ? NS : 6;
                constexpr bool VBOTH = (DV == 64);
                f32x16 st[2];
#pragma unroll
                for (int i = 0; i < 16; ++i) { st[0][i] = 0.f; st[1][i] = 0.f; }
#pragma unroll
                for (int g0 = 0; g0 < NS; g0 += G) {
                    bf16x8 ka[G], kc[G];
#pragma unroll
                    for (int s = 0; s < G; ++s) {
                        ka[s] = *(const bf16x8*)(kb_l + r * KST + (koff + 8 * h) * 2 + (g0 + s) * 32);
                        kc[s] = *(const bf16x8*)(kb_l + (32 + r) * KST + (koff + 8 * h) * 2 + (g0 + s) * 32);
                    }
                    __builtin_amdgcn_sched_barrier(0);
#pragma unroll
                    for (int s = 0; s < G; ++s) {
                        st[0] = __builtin_amdgcn_mfma_f32_32x32x16_bf16(ka[s], qf[g0 + s], st[0], 0, 0, 0);
                        st[1] = __builtin_amdgcn_mfma_f32_32x32x16_bf16(kc[s], qf[g0 + s], st[1], 0, 0, 0);
                    }
                }
                s16x4 vlo[VBOTH ? 2 : 1][2][NDB], vhi[VBOTH ? 2 : 1][2][NDB];
#pragma unroll
                for (int kb = 0; kb < (VBOTH ? 2 : 1); ++kb)
#pragma unroll
                    for (int s2 = 0; s2 < 2; ++s2)
#pragma unroll
                        for (int d = 0; d < NDB; ++d) {
                            const char* vp = vb_l + (32 * d + r) * VST + (32 * kb + 16 * s2 + 4 * h) * 2;
                            vlo[kb][s2][d] = *(const s16x4*)vp; vhi[kb][s2][d] = *(const s16x4*)(vp + 16);
                        }
                __builtin_amdgcn_sched_barrier(0);
                const bool MASKED = (MODE != 0) && LAT;
                float mx = -3e38f;
                if (MASKED) {
#pragma unroll
                    for (int kb = 0; kb < 2; ++kb)
#pragma unroll
                        for (int i = 0; i < 16; ++i) {
                            float tv = st[kb][i] * cs;
                            if (MODE == 1) {
                                const int d = kt * 64 + 32 * kb + crow(i, h) - qpos; const bool valid = (d <= 128) && (d >= -128); tv = valid ? tv : -1e30f;
                            } else if (MODE == 2) {
                                const int kc2 = 32 * kb + crow(i, h);
                                const bool valid = (kc2 >= cstart) && (kc2 < cstart + 16);
                                int bi = (kt - qrow + 7) * 31 + (kc2 - qcol + 15); bi = valid ? bi : 0;
                                const float bias = rpbL[bi];
                                tv = valid ? (tv + bias * LOG2E) : -1e30f;
                            }
                            st[kb][i] = tv; mx = fmaxf(mx, tv);
                        }
                } else {
#pragma unroll
                    for (int kb = 0; kb < 2; ++kb)
#pragma unroll
                        for (int i = 0; i < 16; ++i) mx = fmaxf(mx, st[kb][i]);
                    mx *= cs;
                }
                mx = fmaxf(mx, bperm(mx, x32));
                const float m_new = fmaxf(m_run, mx);
                if (__any(m_new > m_run)) {
                    const float alpha = fexp2(m_run - m_new);
                    l_run *= alpha;
#pragma unroll
                    for (int d = 0; d < NDB; ++d)
#pragma unroll
                        for (int i = 0; i < 16; ++i) ot[d][i] *= alpha;
                }
                m_run = m_new;
                float rs = 0.f;
#pragma unroll
                for (int kb = 0; kb < 2; ++kb)
#pragma unroll
                    for (int i = 0; i < 16; ++i) {
                        const float p = MASKED ? fexp2(st[kb][i] - m_new) : fexp2(__builtin_fmaf(st[kb][i], cs, -m_new));
                        st[kb][i] = p; rs += p;
                    }
                l_run += rs;
#pragma unroll
                for (int kb = 0; kb < 2; ++kb) {
                    if (!VBOTH && kb == 1) {
#pragma unroll
                        for (int s2 = 0; s2 < 2; ++s2)
#pragma unroll
                            for (int d = 0; d < NDB; ++d) {
                                const char* vp = vb_l + (32 * d + r) * VST + (32 + 16 * s2 + 4 * h) * 2;
                                vlo[0][s2][d] = *(const s16x4*)vp; vhi[0][s2][d] = *(const s16x4*)(vp + 16);
                            }
                    }
                    const int vs = VBOTH ? kb : 0;
#pragma unroll
                    for (int s2 = 0; s2 < 2; ++s2) {
                        u32x4 pw;
                        pw.x = pack2(st[kb][8 * s2 + 0], st[kb][8 * s2 + 1]); pw.y = pack2(st[kb][8 * s2 + 2], st[kb][8 * s2 + 3]);
                        pw.z = pack2(st[kb][8 * s2 + 4], st[kb][8 * s2 + 5]); pw.w = pack2(st[kb][8 * s2 + 6], st[kb][8 * s2 + 7]);
                        const bf16x8 pf = __builtin_bit_cast(bf16x8, pw);
#pragma unroll
                        for (int d = 0; d < NDB; ++d) {
                            const bf16x8 vf = __builtin_shufflevector(vlo[vs][s2][d], vhi[vs][s2][d], 0, 1, 2, 3, 4, 5, 6, 7);
                            ot[d] = __builtin_amdgcn_mfma_f32_32x32x16_bf16(vf, pf, ot[d], 0, 0, 0);
                        }
                    }
                }
              } else {
                constexpr bool PREK = NS <= 4;
                bf16x8 kf[NS];
#pragma unroll
                for (int s = 0; s < NS; ++s) kf[s] = *(const bf16x8*)(kb_l + r * KST + (koff + 8 * h) * 2 + s * 32);
#pragma unroll
                for (int kb = 0; kb < 2; ++kb) {
                    f32x16 st;
#pragma unroll
                    for (int i = 0; i < 16; ++i) st[i] = 0.f;
                    __builtin_amdgcn_sched_barrier(0);
#pragma unroll
                    for (int s = 0; s < NS; ++s) st = __builtin_amdgcn_mfma_f32_32x32x16_bf16(kf[s], qf[s], st, 0, 0, 0);
                    s16x4 vlo[2][NDB], vhi[2][NDB];
#pragma unroll
                    for (int s2 = 0; s2 < 2; ++s2)
#pragma unroll
                        for (int d = 0; d < NDB; ++d) {
                            const char* vp = vb_l + (32 * d + r) * VST + (32 * kb + 16 * s2 + 4 * h) * 2;
                            vlo[s2][d] = *(const s16x4*)vp; vhi[s2][d] = *(const s16x4*)(vp + 16);
                        }
                    if (kb == 0) {
                        if (PREK) {
#pragma unroll
                            for (int s = 0; s < NS; ++s) kf[s] = *(const bf16x8*)(kb_l + (32 + r) * KST + (koff + 8 * h) * 2 + s * 32);
                        }
                    }
                    __builtin_amdgcn_sched_barrier(0);
                    const bool MASKED = (MODE != 0) && LAT;
                    float mx = -3e38f;
                    if (MASKED) {
#pragma unroll
                        for (int i = 0; i < 16; ++i) {
                            float tv = st[i] * cs;
                            if (MODE == 1) {
                                const int d = kt * 64 + 32 * kb + crow(i, h) - qpos; const bool valid = (d <= 128) && (d >= -128); tv = valid ? tv : -1e30f;
                            } else if (MODE == 2) {
                                const int kc = 32 * kb + crow(i, h);
                                const bool valid = (kc >= cstart) && (kc < cstart + 16);
                                int bi = (kt - qrow + 7) * 31 + (kc - qcol + 15); bi = valid ? bi : 0;
                                const float bias = rpbL[bi];
                                tv = valid ? (tv + bias * LOG2E) : -1e30f;
                            }
                            st[i] = tv; mx = fmaxf(mx, tv);
                        }
                    } else {
#pragma unroll
                        for (int i = 0; i < 16; ++i) mx = fmaxf(mx, st[i]);
                        mx *= cs;
                    }
                    mx = fmaxf(mx, bperm(mx, x32));
                    const float m_new = fmaxf(m_run, mx);
                    if (__any(m_new > m_run)) {
                        const float alpha = fexp2(m_run - m_new);
                        l_run *= alpha;
#pragma unroll
                        for (int d = 0; d < NDB; ++d)
#pragma unroll
                            for (int i = 0; i < 16; ++i) ot[d][i] *= alpha;
                    }
                    m_run = m_new;
                    float rs = 0.f;
                    if (MASKED) {
#pragma unroll
                        for (int i = 0; i < 16; ++i) { const float p = fexp2(st[i] - m_new); st[i] = p; rs += p; }
                    } else {
#pragma unroll
                        for (int i = 0; i < 16; ++i) { const float p = fexp2(__builtin_fmaf(st[i], cs, -m_new)); st[i] = p; rs += p; }
                    }
                    l_run += rs;
#pragma unroll
                    for (int s2 = 0; s2 < 2; ++s2) {
                        u32x4 pw;
                        pw.x = pack2(st[8 * s2 + 0], st[8 * s2 + 1]); pw.y = pack2(st[8 * s2 + 2], st[8 * s2 + 3]);
                        pw.z = pack2(st[8 * s2 + 4], st[8 * s2 + 5]); pw.w = pack2(st[8 * s2 + 6], st[8 * s2 + 7]);
                        const bf16x8 pf = __builtin_bit_cast(bf16x8, pw);
#pragma unroll
                        for (int d = 0; d < NDB; ++d) {
                            const bf16x8 vf = __builtin_shufflevector(vlo[s2][d], vhi[s2][d], 0, 1, 2, 3, 4, 5, 6, 7);
                            ot[d] = __builtin_amdgcn_mfma_f32_32x32x16_bf16(vf, pf, ot[d], 0, 0, 0);
                        }
                    }
                    if (kb == 0) {
                        if (!PREK) {
#pragma unroll
                            for (int s = 0; s < NS; ++s) kf[s] = *(const bf16x8*)(kb_l + (32 + r) * KST + (koff + 8 * h) * 2 + s * 32);
                        }
                    }
                }
              }
            }
            store_tile((t + 1) & 1, D2 ? (PAR ^ 1) : 0);
            __syncthreads();
        };
        for (int t = 0; t < 4; t += 2) { tile_body(t, false, 0); tile_body(t + 1, false, 1); }
        if (T > 4) {
            load_q(true);
            for (int t = 4; t < T; t += 2) { tile_body(t, true, 0); if (t + 1 < T) tile_body(t + 1, true, 1); }
        }
        }
        float l_tot = l_run + bperm(l_run, x32);
        if (MODE == 1) l_tot += fexp2(a.sink[hh] * LOG2E - m_run);
        const float inv = 1.0f / l_tot;
        if (!PAIR) {
            bf16_t* op = a.ao + (size_t)tokq * 1024 + hh * DV;
#pragma unroll
            for (int d = 0; d < NDB; ++d)
#pragma unroll
                for (int g = 0; g < 4; ++g) {
                    f32x4 v = {ot[d][4 * g] * inv, ot[d][4 * g + 1] * inv, ot[d][4 * g + 2] * inv, ot[d][4 * g + 3] * inv};
                    *(u32x2*)(op + 32 * d + 8 * g + 4 * h) = pack4(v);
                }
        } else {
            float* ex = (float*)lds;
            if (gsel == 1) {
#pragma unroll
                for (int d = 0; d < NDB; ++d)
#pragma unroll
                    for (int i = 0; i < 16; ++i) ex[(wq * 128 + 32 * d + crow(i, h)) * 32 + r] = ot[d][i] * inv;
            }
            __syncthreads();
            if (gsel == 0) {
                float ss = 0.f;
#pragma unroll
                for (int d = 0; d < NDB; ++d)
#pragma unroll
                    for (int i = 0; i < 16; ++i) {
                        const float o1 = ex[(wq * 128 + 32 * d + crow(i, h)) * 32 + r];
                        const float v = ot[d][i] * inv - lam * o1;
                        ot[d][i] = v; ss += v * v;
                    }
                ss += bperm(ss, x32);
                const float rstd = rsqrtf(ss * (1.0f / 128.0f) + EPSV) * (1.0f - a.lam_init);
                bf16_t* op = a.ao + (size_t)tokq * 1024 + hh * DV;
#pragma unroll
                for (int d = 0; d < NDB; ++d)
#pragma unroll
                    for (int g = 0; g < 4; ++g) {
                        const int dd = 32 * d + 8 * g + 4 * h;
                        f32x4 gn = *(const f32x4*)(a.ng + dd);
                        f32x4 v = {ot[d][4 * g] * rstd * gn[0], ot[d][4 * g + 1] * rstd * gn[1], ot[d][4 * g + 2] * rstd * gn[2], ot[d][4 * g + 3] * rstd * gn[3]};
                        *(u32x2*)(op + dd) = pack4(v);
                    }
            }
            __syncthreads();
        }
    }
}

DI void norm_phase(float* X, const float* g, const float* mods_l, int shift_i, int scale_i, bf16_t* H, int nrows, const int tid, const float* part, int npart) {
    const int wave = tid >> 6, lane = tid & 63;
    const int gw = blockIdx.x * 8 + wave, nw = gridDim.x * 8;
    for (int row = gw; row < nrows; row += nw) {
        float* xp = X + (size_t)row * DM;
        f32x4 v[4]; float ss = 0.f;
#pragma unroll
        for (int i = 0; i < 4; ++i) v[i] = *(const f32x4*)(xp + i * 256 + lane * 4);
        if (row >= NLAT && npart > 0) {
            for (int sidx = 0; sidx < npart; ++sidx) {
                const float* pp = part + ((size_t)sidx * (MT - NLAT) + (row - NLAT)) * DM;
#pragma unroll
                for (int i = 0; i < 4; ++i) v[i] += *(const f32x4*)(pp + i * 256 + lane * 4);
            }
#pragma unroll
            for (int i = 0; i < 4; ++i) *(f32x4*)(xp + i * 256 + lane * 4) = v[i];
        }
#pragma unroll
        for (int i = 0; i < 4; ++i) ss += v[i][0] * v[i][0] + v[i][1] * v[i][1] + v[i][2] * v[i][2] + v[i][3] * v[i][3];
        ss = wave_sum(ss, lane);
        const float rstd = rsqrtf(ss * (1.0f / 1024.0f) + EPSV);
        const float* mp = mods_l + (size_t)mod_row(row) * 9216;
#pragma unroll
        for (int i = 0; i < 4; ++i) {
            const int col = i * 256 + lane * 4;
            f32x4 gg = *(const f32x4*)(g + col), sh = *(const f32x4*)(mp + shift_i * 1024 + col), sc = *(const f32x4*)(mp + scale_i * 1024 + col);
            f32x4 y = (v[i] * rstd) * gg;
            y = y * (sc + 1.0f) + sh;
            *(u32x2*)(H + (size_t)row * DM + col) = pack4(y);
        }
    }
}

DI void final_phase(const float* X, const float* g, float* out, const int tid) {
    const int wave = tid >> 6, lane = tid & 63;
    const int gw = blockIdx.x * 8 + wave, nw = gridDim.x * 8;
    for (int row = gw; row < NLAT; row += nw) {
        const float* xp = X + (size_t)row * DM;
        f32x4 v[4]; float ss = 0.f;
#pragma unroll
        for (int i = 0; i < 4; ++i) { v[i] = *(const f32x4*)(xp + i * 256 + lane * 4); ss += v[i][0] * v[i][0] + v[i][1] * v[i][1] + v[i][2] * v[i][2] + v[i][3] * v[i][3]; }
        ss = wave_sum(ss, lane);
        const float rstd = rsqrtf(ss * (1.0f / 1024.0f) + EPSV);
#pragma unroll
        for (int i = 0; i < 4; ++i) {
            const int col = i * 256 + lane * 4;
            f32x4 gg = *(const f32x4*)(g + col);
            *(f32x4*)(out + (size_t)row * DM + col) = (v[i] * rstd) * gg;
        }
    }
}

struct ConvJob { const float* src; int srcN, K, dstN, mode, coloff; const float* scale; size_t dst; };

DI int rope_dim(int w, int grp) { return (w < 16) ? grp * 16 + w : 32 + grp * 16 + (w - 16); }
DI int conv_perm(int mode, int coloff, int n) {
    switch (mode) {
    case 0: return coloff + n;
    case 1: { const int t = n >> 8, q = n & 255, bj = q >> 7, wcc = (q & 127) >> 5, nn = (q & 31) >> 4, i = q & 15;
              return (bj ? 2816 : 0) + t * 128 + wcc * 32 + (i >> 2) * 8 + nn * 4 + (i & 3); }
    case 2: { const int blk = n >> 6, grp = (n >> 5) & 1, w = n & 31; return coloff + blk * 64 + rope_dim(w, grp); }
    case 3: { if (n < 768) return n; if (n >= 832) return -1; const int rr = n - 768; return 768 + rope_dim(rr & 31, rr >> 5); }
    case 4: { const int g = n >> 5, head = g / 6, gi = g - head * 6, w = n & 31; if (gi < 4) return head * 192 + gi * 32 + w; return head * 192 + 128 + rope_dim(w, gi - 4); }
    case 7: { const int i = n & 15, nn = (n >> 4) & 1; return (n & ~31) + 8 * (i >> 2) + 4 * nn + (i & 3); }
    case 5: return (n >> 7) * 256 + (n & 127);
    default: return (n >> 7) * 256 + 128 + (n & 127);
    }
}

DI ConvJob get_conv_job(const Params& p, int j) {
    ConvJob c; c.scale = nullptr; c.coloff = 0; c.mode = 0; c.K = 1024; c.srcN = 1024; c.dstN = 1024;
    if (j < 8) { c.src = p.in[8] + (size_t)j * 1024 * 5632; c.srcN = 5632; c.dstN = 5632; c.mode = 1; c.dst = W_IN + (size_t)j * 5632 * 1024; }
    else if (j < 16) { c.src = p.in[9] + (size_t)(j - 8) * 2816 * 1024; c.K = 2816; c.mode = 7; c.dst = W_OUT + (size_t)(j - 8) * 1024 * 2816; }
    else switch (j) {
    case 16: c.src = p.in[10]; c.srcN = 832; c.mode = 3; c.dst = W_MLA_DOWN; break;
    case 17: c.src = p.in[13]; c.srcN = 1536; c.K = 512; c.dstN = 1536; c.mode = 4; c.scale = p.in[11]; c.dst = W_MLA_UQ; break;
    case 18: c.src = p.in[14]; c.srcN = 2048; c.K = 256; c.mode = 5; c.scale = p.in[12]; c.dst = W_MLA_UK; break;
    case 19: c.src = p.in[14]; c.srcN = 2048; c.K = 256; c.mode = 6; c.scale = p.in[12]; c.dst = W_MLA_UV; break;
    case 20: c.src = p.in[15]; c.mode = 7; c.dst = W_MLA_WO; break;
    case 21: c.src = p.in[16]; c.srcN = 1536; c.dstN = 1280; c.mode = 2; c.dst = W_SWA_QK; break;
    case 22: c.src = p.in[16]; c.srcN = 1536; c.dstN = 256; c.coloff = 1280; c.dst = W_SWA_V; break;
    case 23: c.src = p.in[18]; c.mode = 7; c.dst = W_SWA_WO; break;
    case 24: c.src = p.in[19]; c.srcN = 3072; c.dstN = 2048; c.dst = W_NA_QK; break;
    case 25: c.src = p.in[19]; c.srcN = 3072; c.coloff = 2048; c.dst = W_NA_V; break;
    case 26: c.src = p.in[21]; c.mode = 7; c.dst = W_NA_WO; break;
    case 27: c.src = p.in[22]; c.srcN = 3072; c.dstN = 2048; c.mode = 2; c.dst = W_DIFF_QK; break;
    case 28: c.src = p.in[22]; c.srcN = 3072; c.coloff = 2048; c.dst = W_DIFF_V; break;
    default: c.src = p.in[25]; c.mode = 7; c.dst = W_DIFF_WO; break;
    }
    return c;
}
constexpr int N_CONV = 30;

DI void prep_phase(const Params& p, char* lds, const int tid) {
    bf16_t* W = (bf16_t*)(p.ws + OFF_W);
    {
        constexpr int TST = 528;
        int rot = 0;
        for (int j = 0; j < N_CONV; ++j) {
            const ConvJob c = get_conv_job(p, j);
            const int nkt = c.K / 256, units = (c.dstN / 64) * nkt;
            int first = (int)blockIdx.x - rot; if (first < 0) first += gridDim.x;
            for (int u = first; u < units; u += gridDim.x) {
                const int ntile = u / nkt, kt = u % nkt;
                const int nl = tid & 63, kk = tid >> 6;
                const int sc = conv_perm(c.mode, c.coloff, ntile * 64 + nl);
                const int k0 = kt * 256 + kk * 32;
                float v[32];
#pragma unroll
                for (int i = 0; i < 32; ++i) v[i] = (sc >= 0) ? c.src[(size_t)(k0 + i) * c.srcN + sc] : 0.f;
                if (c.scale) {
#pragma unroll
                    for (int i = 0; i < 32; ++i) v[i] *= c.scale[k0 + i];
                }
#pragma unroll
                for (int i = 0; i < 16; ++i) *(unsigned*)(lds + nl * TST + (kk * 32 + 2 * i) * 2) = pack2(v[2 * i], v[2 * i + 1]);
                __syncthreads();
#pragma unroll
                for (int i = 0; i < 4; ++i) {
                    const int idx = tid + i * NTHREADS, n = idx >> 5, ch = idx & 31;
                    u32x4 w = *(const u32x4*)(lds + n * TST + ch * 16);
                    *(u32x4*)(W + c.dst + (size_t)(ntile * 64 + n) * c.K + kt * 256 + ch * 8) = w;
                }
                __syncthreads();
            }
            rot = (rot + units) % (int)gridDim.x;
        }
    }
    {
        float* sc = (float*)lds;
        float* red = (float*)(lds + 20480);
        for (int i = tid; i < 5 * 1024; i += NTHREADS) {
            const int rr = i >> 10, k = i & 1023;
            const float cv = rr < 4 ? p.in[1][rr * 1024 + k] : p.in[3][k];
            sc[i] = siluf(cv);
        }
        __syncthreads();
        float* mods = (float*)(p.ws + OFF_MODS);
        const int c4 = tid & 31, ks = tid >> 5;
        for (int u = blockIdx.x; u < 4 * 72; u += gridDim.x) {
            const int l = u / 72, n0 = (u % 72) * 128;
            const float* wp = p.in[4] + (size_t)l * 1024 * 9216 + n0 + c4 * 4;
            f32x4 a0 = {0, 0, 0, 0}, a1 = a0, a2 = a0, a3 = a0, a4 = a0;
#pragma unroll 8
            for (int kk = 0; kk < 64; ++kk) {
                const int k = ks * 64 + kk;
                const f32x4 w = *(const f32x4*)(wp + (size_t)k * 9216);
                a0 += w * sc[k]; a1 += w * sc[1024 + k]; a2 += w * sc[2048 + k]; a3 += w * sc[3072 + k]; a4 += w * sc[4096 + k];
            }
            *(f32x4*)(red + (ks * 5 + 0) * 128 + c4 * 4) = a0; *(f32x4*)(red + (ks * 5 + 1) * 128 + c4 * 4) = a1;
            *(f32x4*)(red + (ks * 5 + 2) * 128 + c4 * 4) = a2; *(f32x4*)(red + (ks * 5 + 3) * 128 + c4 * 4) = a3;
            *(f32x4*)(red + (ks * 5 + 4) * 128 + c4 * 4) = a4;
            __syncthreads();
            for (int i = tid; i < 5 * 128; i += NTHREADS) {
                const int rr = i >> 7, cc = i & 127;
                float s = p.in[5][l * 9216 + n0 + cc];
#pragma unroll
                for (int q = 0; q < 16; ++q) s += red[(q * 5 + rr) * 128 + cc];
                mods[((size_t)l * 5 + rr) * 9216 + n0 + cc] = s;
            }
            __syncthreads();
        }
    }
    {
        float* cosT = (float*)(p.ws + OFF_COS); float* sinT = (float*)(p.ws + OFF_SIN);
        for (int i = blockIdx.x * NTHREADS + tid; i < 4096 * 32; i += gridDim.x * NTHREADS) {
            const int pos = i >> 5, d = i & 31, f = d & 15;
            const float inv = expf(-9.210340371976184f * (float)f / 16.0f);
            const float base = (d < 16) ? (float)(pos >> 6) : (float)(pos & 63);
            const float ang = base * inv;
            float rev = ang * 0.15915494309189535f; rev = rev - floorf(rev);
            cosT[i] = __builtin_amdgcn_cosf(rev); sinT[i] = __builtin_amdgcn_sinf(rev);
        }
    }
    {
        f32x4* X4 = (f32x4*)(p.ws + OFF_X);
        const f32x4* x4 = (const f32x4*)p.in[0]; const f32x4* c4p = (const f32x4*)p.in[2];
        const size_t nlat4 = (size_t)NLAT * 256, nall4 = (size_t)MT * 256;
        for (size_t i = (size_t)blockIdx.x * NTHREADS + tid; i < nall4; i += (size_t)gridDim.x * NTHREADS)
            X4[i] = i < nlat4 ? x4[i] : c4p[i - nlat4];
    }
}

constexpr int N_PHASES = 1 + 4 * 11 + 1;
__host__ __device__ inline bool phase_is_noop(int ph) {
    if (ph == 0 || ph == N_PHASES - 1) return false;
    const int layer = (ph - 1) / 11, slot = (ph - 1) % 11;
    return slot == 5 && layer != 0;
}

DI GemmJob get_job(const Params& p, int layer, int slot, int jidx, int& nj, const bool dry) {
    char* ws = p.ws;
    bf16_t* W = (bf16_t*)(ws + OFF_W);
    float* X = (float*)(ws + OFF_X);
    bf16_t* H = (bf16_t*)(ws + OFF_H);
    bf16_t* R = (bf16_t*)(ws + OFF_R);
    bf16_t* RQ = (bf16_t*)(ws + OFF_R + R_Q); bf16_t* RK = (bf16_t*)(ws + OFF_R + R_K);
    bf16_t* RVT = (bf16_t*)(ws + OFF_R + R_VT); bf16_t* RD = (bf16_t*)(ws + OFF_R + R_DRAW);
    const float* mods_l = (const float*)(ws + OFF_MODS) + (size_t)layer * 5 * 9216;
    float* stats = (float*)(ws + OFF_STATS);
    const float* cosT = (const float*)(ws + OFF_COS); const float* sinT = (const float*)(ws + OFF_SIN);
    const bool last = layer == 3;
    GemmJob j; j.o0 = j.o1 = nullptr; j.o2 = nullptr; j.f0 = j.f1 = nullptr; j.i0 = 0; j.s0 = 0.f; j.ksplit = 1; j.row0 = 0;
    if (slot == 1 || slot == 9) {
        const int f = slot == 1 ? 0 : 1;
        j.A = H; j.lda = 1024; j.B = W + W_IN + (size_t)(layer * 2 + f) * 5632 * 1024; j.ldb = 1024;
        j.M = (last && f == 1) ? NLAT : MT; j.N = 5632; j.K = 1024; j.epi = EPI_SWIGLU; j.o0 = R;
        nj = 1; return j;
    }
    if (slot == 2 || slot == 10) {
        const int f = slot == 2 ? 0 : 1;
        j.A = R; j.lda = DFF; j.B = W + W_OUT + (size_t)(layer * 2 + f) * 1024 * 2816; j.ldb = DFF;
        j.M = NLAT; j.N = 1024; j.K = DFF; j.epi = EPI_RESID; j.o0 = X;
        j.f0 = mods_l + (f == 0 ? 2 : 8) * 1024; j.s0 = 0.5f;
        nj = (last && f == 1) ? 1 : 2;
        if (dry) { nj = 1; j.s0 = 0.f; }
        if (jidx == 1) { j.A = R + (size_t)NLAT * DFF; j.M = MT - NLAT; j.row0 = NLAT; j.ksplit = 11; j.epi = EPI_RESID_ATOMIC; j.o2 = (float*)(ws + OFF_R + R_VT); }
        return j;
    }
    if (slot == 7) {
        const size_t wo = layer == 0 ? W_MLA_WO : layer == 1 ? W_SWA_WO : layer == 2 ? W_NA_WO : W_DIFF_WO;
        j.A = H; j.lda = 1024; j.B = W + wo; j.ldb = 1024; j.M = NLAT; j.N = 1024; j.K = 1024;
        j.epi = EPI_RESID; j.o0 = X; j.f0 = mods_l + 5 * 1024; j.s0 = 1.0f;
        nj = last ? 1 : 2;
        if (dry) { nj = 1; j.s0 = 0.f; }
        if (jidx == 1) { j.A = H + (size_t)NLAT * 1024; j.M = MT - NLAT; j.row0 = NLAT; j.ksplit = 4; j.epi = EPI_RESID_ATOMIC; j.o2 = (float*)(ws + OFF_R + R_DRAW); }
        return j;
    }
    if (slot == 4) {
        if (layer == 0) {
            j.A = H; j.lda = 1024; j.B = W + W_MLA_DOWN; j.ldb = 1024; j.M = MT; j.N = 1024; j.K = 1024;
            j.epi = EPI_MLA_DOWN; j.o0 = RD; j.o1 = RK; j.o2 = stats; j.f0 = cosT; j.f1 = sinT;
            nj = 1; return j;
        }
        j.A = H; j.lda = 1024; j.ldb = 1024; j.M = MT; j.K = 1024; j.o0 = RQ; j.o1 = RK;
        if (layer == 1) { j.B = W + W_SWA_QK; j.N = 1280; j.epi = EPI_ROPE; j.i0 = 16; j.f0 = cosT; j.f1 = sinT; }
        else if (layer == 2) { j.B = W + W_NA_QK; j.N = 2048; j.epi = EPI_PLAIN2; }
        else { j.B = W + W_DIFF_QK; j.N = 2048; j.epi = EPI_ROPE; j.i0 = 16; j.f0 = cosT; j.f1 = sinT; }
        nj = 2;
        if (jidx == 0) return j;
        GemmJob v; v.o1 = nullptr; v.o2 = nullptr; v.f0 = v.f1 = nullptr; v.i0 = 0; v.s0 = 0.f; v.ksplit = 1; v.row0 = 0;
        v.A = W + (layer == 1 ? W_SWA_V : layer == 2 ? W_NA_V : W_DIFF_V); v.lda = 1024; v.B = H; v.ldb = 1024;
        v.M = layer == 1 ? 256 : 1024; v.N = MT; v.K = 1024; v.epi = EPI_VT; v.o0 = RVT;
        return v;
    }
    j.A = RD; j.lda = 1024; j.B = W + W_MLA_UQ; j.ldb = 512; j.M = MT; j.N = 1536; j.K = 512;
    j.epi = EPI_MLA_Q; j.o0 = RQ; j.o1 = (void*)cosT; j.f0 = stats; j.f1 = sinT;
    nj = 3;
    if (jidx == 0) return j;
    GemmJob k = j; k.A = RD + 512; k.B = W + W_MLA_UK; k.ldb = 256; k.N = 1024; k.K = 256; k.epi = EPI_MLA_K; k.o0 = RK; k.o1 = nullptr; k.f1 = nullptr;
    if (jidx == 1) return k;
    GemmJob v = k; v.A = W + W_MLA_UV; v.lda = 256; v.B = RD + 512; v.ldb = 1024; v.M = 1024; v.N = MT; v.epi = EPI_VT; v.o0 = RVT; v.i0 = 1;
    return v;
}

DI void run_phase(const Params& p, int ph, char* lds, const int wave_s, const bool dry = false) {
    char* ws = p.ws;
    float* X = (float*)(ws + OFF_X);
    bf16_t* H = (bf16_t*)(ws + OFF_H);
#ifndef NO_PREP
    if (ph == 0) { prep_phase(p, lds, fresh_tid(wave_s)); return; }
#endif
    if (ph == N_PHASES - 1) { final_phase(X, p.in[7], p.out, fresh_tid(wave_s)); return; }
    const int layer = (ph - 1) / 11, slot = (ph - 1) % 11;
    const float* mods_l = (const float*)(ws + OFF_MODS) + (size_t)layer * 5 * 9216;
    const bool last = layer == 3;
    if (slot == 0 || slot == 3 || slot == 8) {
        const int sub = slot == 0 ? 0 : slot == 3 ? 1 : 2;
        const float* part = (sub == 2) ? (const float*)(ws + OFF_R + R_DRAW) : (const float*)(ws + OFF_R + R_VT);
        const int npart = (sub == 2) ? 4 : ((sub == 0 && layer == 0) ? 0 : 11);
        norm_phase(X, p.in[6] + (size_t)(layer * 3 + sub) * 1024, mods_l, sub * 3, sub * 3 + 1, H, (last && sub == 2) ? NLAT : MT, fresh_tid(wave_s), part, (last && sub == 2) ? 0 : npart);
        return;
    }
#ifndef NO_ATTN
    if (slot == 6) {
        const int tid = fresh_tid(wave_s);
        AttnArgs a;
        a.q = (const bf16_t*)(ws + OFF_R + R_Q); a.k = (const bf16_t*)(ws + OFF_R + R_K); a.vt = (const bf16_t*)(ws + OFF_R + R_VT);
        a.ao = H; a.sink = nullptr; a.rpb = nullptr; a.lamp = nullptr; a.ng = nullptr; a.lam_init = 0.f; a.ctx_units = last ? 0 : 1;
        if (layer == 0) {
            a.q_ts = 2048; a.q_hs = 256; a.q_rot = 128; a.q_plain = 192; a.k_ts = 1536; a.k_hs = 192; a.NH = 8; a.scale = 0.07216878364870322f;
            attn_phase<192, 128, 0, false>(a, lds, tid);
        } else if (layer == 1) {
            a.q_ts = 2048; a.q_hs = 128; a.q_rot = 0; a.q_plain = 64; a.k_ts = 256; a.k_hs = 64; a.NH = 16; a.scale = 0.125f; a.sink = p.in[17];
            attn_phase<64, 64, 1, false>(a, lds, tid);
        } else if (layer == 2) {
            a.q_ts = 1024; a.q_hs = 64; a.q_rot = 0; a.q_plain = 0; a.k_ts = 1024; a.k_hs = 64; a.NH = 16; a.scale = 0.125f; a.rpb = p.in[20];
            attn_phase<64, 64, 2, false>(a, lds, tid);
        } else {
            a.q_ts = 2048; a.q_hs = 128; a.q_rot = 0; a.q_plain = 64; a.k_ts = 1024; a.k_hs = 128; a.NH = 8; a.scale = 0.125f;
            a.lamp = p.in[23]; a.ng = p.in[24]; a.lam_init = 0.5560582f;
            attn_phase<64, 128, 0, true>(a, lds, tid);
        }
        return;
    }
#endif
#ifndef NO_GEMM
    int nj = 1, rot = 0;
#pragma unroll 1
    for (int j = 0; j < nj; ++j) {
        const GemmJob job = get_job(p, layer, slot, j, nj, dry);
        gemm_run(job, lds, wave_s, rot);
        rot = (rot + (job.M / BM) * (job.N / BM) * job.ksplit) % (int)gridDim.x;
    }
#endif
}

__global__ void __launch_bounds__(NTHREADS) mega_kernel(Params p, int ph_lo, int ph_hi) {
    extern __shared__ __attribute__((aligned(16))) char lds[];
    cg::grid_group grid = cg::this_grid();
    const int wave_s = __builtin_amdgcn_readfirstlane(threadIdx.x >> 6);
    if (ph_lo > ph_hi) grid.sync();
    XcdBarrier xb; xb.bar = (unsigned*)(p.ws + OFF_BAR); xb.x = xb_xcc_id(); xb.st = (volatile LAS unsigned*)&lds[131072];
    if (ph_hi - ph_lo > 1) {
        const bool t0 = fresh_tid(wave_s) == 0;
        if (t0) { xb.st[0] = 0u; xb.st[1] = 0u; }
        __syncthreads();
        if (t0) (void)xb_add(&xb.bar[XB_XCNT(xb.x)], 1u);
    }
#pragma unroll 1
    for (int ph = ph_lo; ph < ph_hi; ++ph) {
        if (phase_is_noop(ph)) continue;
        run_phase(p, ph, lds, wave_s);
        if (PROBE_DUP) {
            const int slot_ = (ph >= 1 && ph < N_PHASES - 1) ? (ph - 1) % 11 : -1;
            bool dup = false;
            if (PROBE_DUP == 1) dup = ph == 0;
            if (PROBE_DUP == 3) dup = slot_ == 6;
            if (PROBE_DUP >= 30 && PROBE_DUP < 34) dup = slot_ == 6 && (ph - 1) / 11 == PROBE_DUP - 30;
            if (PROBE_DUP == 4) dup = slot_ == 0 || slot_ == 3 || slot_ == 8;
            if (PROBE_DUP == 5) dup = slot_ == 1 || slot_ == 9;
            if (PROBE_DUP == 6) dup = slot_ == 4 || slot_ == 5;
            if (PROBE_DUP == 7) dup = slot_ == 2 || slot_ == 10;
            if (PROBE_DUP == 8) dup = slot_ == 7;
            if (PROBE_DUP == 2) xcd_barrier(xb, fresh_tid(wave_s) == 0);
            if (dup) { xcd_barrier(xb, fresh_tid(wave_s) == 0); run_phase(p, ph, lds, wave_s, PROBE_DUP >= 7); }
        }
        if (ph + 1 < ph_hi) xcd_barrier(xb, fresh_tid(wave_s) == 0);
    }
}

extern "C" void kernel_launch(void* const* d_in, const int* in_sizes, int n_in, void* d_out, int out_size, void* d_ws, size_t ws_size,
                              hipStream_t stream) {
    static int grid_blocks = 0;
    if (!grid_blocks) {
        (void)hipFuncSetAttribute((const void*)mega_kernel, hipFuncAttributeMaxDynamicSharedMemorySize, LDS_BYTES);
        int dev = 0, cus = 0, per_cu = 0;
        (void)hipGetDevice(&dev);
        (void)hipDeviceGetAttribute(&cus, hipDeviceAttributeMultiprocessorCount, dev);
        (void)hipOccupancyMaxActiveBlocksPerMultiprocessor(&per_cu, mega_kernel, NTHREADS, LDS_BYTES);
        if (per_cu < 1) per_cu = 1;
        if (per_cu > 1) per_cu = 1;
        grid_blocks = cus * per_cu;
        grid_blocks -= grid_blocks % 8;
        if (ws_size < WS_NEED) fprintf(stderr, "workspace too small: %zu < %zu\n", ws_size, (size_t)WS_NEED);
    }
    Params p{};
    for (int i = 0; i < 26; ++i) p.in[i] = (const float*)d_in[i];
    p.out = (float*)d_out; p.ws = (char*)d_ws;
#if MK_SINGLE
    (void)hipMemsetAsync((char*)d_ws + OFF_BAR, 0, 16384, stream);
    int lo = 0, hi = N_PHASES;
    void* args[] = {&p, &lo, &hi};
    hipError_t e = hipLaunchCooperativeKernel((const void*)mega_kernel, dim3(grid_blocks), dim3(NTHREADS), args, LDS_BYTES, stream);
    if (e != hipSuccess) fprintf(stderr, "cooperative launch failed: %s (grid %d)\n", hipGetErrorString(e), grid_blocks);
#else
    for (int ph = 0; ph < N_PHASES; ++ph) {
        if (phase_is_noop(ph)) continue;
        mega_kernel<<<dim3(grid_blocks), dim3(NTHREADS), LDS_BYTES, stream>>>(p, ph, ph + 1);
    }
#endif
}
```

```cpp
#include <hip/hip_runtime.h>
#include <hip/hip_cooperative_groups.h>
#include <cstdio>
#include <cstdint>
namespace cg = cooperative_groups;

#ifndef MK_SINGLE
#define MK_SINGLE 1
#endif
#define PROBE_DUP 0

typedef unsigned short bf16_t;
typedef short bf16x8 __attribute__((ext_vector_type(8)));
typedef short s16x4 __attribute__((ext_vector_type(4)));
typedef float f32x4 __attribute__((ext_vector_type(4)));
typedef float f32x2 __attribute__((ext_vector_type(2)));
typedef float f32x16 __attribute__((ext_vector_type(16)));
typedef unsigned u32x4 __attribute__((ext_vector_type(4)));
typedef unsigned u32x2 __attribute__((ext_vector_type(2)));
typedef __bf16 bf2_t __attribute__((ext_vector_type(2)));
#define DI __device__ __forceinline__

constexpr int MT = 17408;
constexpr int NLAT = 16384;
constexpr int DM = 1024;
constexpr int DFF = 2816;
constexpr int NTHREADS = 512;
constexpr int LDS_BYTES = 131072 + 16;
constexpr float EPSV = 1e-6f;
constexpr float LOG2E = 1.4426950408889634f;
constexpr float RESCALE_THR = 8.0f;

constexpr size_t al256(size_t x) { return (x + 255) & ~(size_t)255; }
constexpr size_t OFF_BAR = 0;
constexpr size_t OFF_MODS = 16384;
constexpr size_t OFF_COS = al256(OFF_MODS + (size_t)4 * 5 * 9216 * 4);
constexpr size_t OFF_SIN = al256(OFF_COS + (size_t)4096 * 32 * 4);
constexpr size_t OFF_STATS = al256(OFF_SIN + (size_t)4096 * 32 * 4);
constexpr size_t OFF_X = al256(OFF_STATS + (size_t)MT * 16 * 4);
constexpr size_t OFF_H = al256(OFF_X + (size_t)MT * 1024 * 4);
constexpr size_t OFF_W = al256(OFF_H + (size_t)MT * 1024 * 2);
constexpr size_t W_IN = 0;
constexpr size_t W_OUT = W_IN + (size_t)8 * 5632 * 1024;
constexpr size_t W_MLA_DOWN = W_OUT + (size_t)8 * 1024 * 2816;
constexpr size_t W_MLA_UQ = W_MLA_DOWN + (size_t)1024 * 1024;
constexpr size_t W_MLA_UK = W_MLA_UQ + (size_t)1536 * 512;
constexpr size_t W_MLA_UV = W_MLA_UK + (size_t)1024 * 256;
constexpr size_t W_MLA_WO = W_MLA_UV + (size_t)1024 * 256;
constexpr size_t W_SWA_QK = W_MLA_WO + (size_t)1024 * 1024;
constexpr size_t W_SWA_V = W_SWA_QK + (size_t)1280 * 1024;
constexpr size_t W_SWA_WO = W_SWA_V + (size_t)256 * 1024;
constexpr size_t W_NA_QK = W_SWA_WO + (size_t)1024 * 1024;
constexpr size_t W_NA_V = W_NA_QK + (size_t)2048 * 1024;
constexpr size_t W_NA_WO = W_NA_V + (size_t)1024 * 1024;
constexpr size_t W_DIFF_QK = W_NA_WO + (size_t)1024 * 1024;
constexpr size_t W_DIFF_V = W_DIFF_QK + (size_t)2048 * 1024;
constexpr size_t W_DIFF_WO = W_DIFF_V + (size_t)1024 * 1024;
constexpr size_t W_TOTAL = W_DIFF_WO + (size_t)1024 * 1024;
constexpr size_t OFF_R = al256(OFF_W + W_TOTAL * 2);
constexpr size_t R_Q = 0;
constexpr size_t R_K = al256(R_Q + (size_t)MT * 2048 * 2);
constexpr size_t R_VT = al256(R_K + (size_t)MT * 1536 * 2);
constexpr size_t R_DRAW = al256(R_VT + (size_t)1024 * MT * 2);
constexpr size_t R_END = al256(R_DRAW + (size_t)MT * 1024 * 2);
constexpr size_t WS_NEED = OFF_R + R_END;

struct Params {
    const float* in[26];
    float* out;
    char* ws;
};

DI unsigned pack2(float lo, float hi) {
    f32x2 v = {lo, hi};
    bf2_t b = __builtin_convertvector(v, bf2_t);
    return __builtin_bit_cast(unsigned, b);
}
DI u32x2 pack4(f32x4 v) { u32x2 r; r.x = pack2(v[0], v[1]); r.y = pack2(v[2], v[3]); return r; }
DI float fexp2(float x) { return __builtin_amdgcn_exp2f(x); }
DI float siluf(float g) { return g * __builtin_amdgcn_rcpf(1.0f + __builtin_amdgcn_exp2f(-g * LOG2E)); }
DI int mod_row(int row) { return row < NLAT ? (row >> 12) : 4; }
template <int M> DI float swz_xor(float x) { return __int_as_float(__builtin_amdgcn_ds_swizzle(__float_as_int(x), (M << 10) | 0x1f)); }
DI float bperm(float x, int addr) { return __int_as_float(__builtin_amdgcn_ds_bpermute(addr, __float_as_int(x))); }
DI float wave_sum(float x, int lane) {
    x += bperm(x, (lane ^ 32) << 2);
    x += swz_xor<16>(x); x += swz_xor<8>(x); x += swz_xor<4>(x); x += swz_xor<2>(x); x += swz_xor<1>(x);
    return x;
}
DI int fresh_tid(int wave_s) {
    int lane;
    asm volatile("v_mbcnt_lo_u32_b32 %0, -1, 0\n\tv_mbcnt_hi_u32_b32 %0, -1, %0" : "=v"(lane));
    return wave_s * 64 + lane;
}


#define XB_TMO      128
#define XB_XCNT(j)  (256  + 64 * (j))
#define XB_XSUB(j)  (1280 + 64 * (j))
#define XB_XGEN(j)  (2304 + 64 * (j))
#define XB_TOP      3328
#define XB_TOPGEN   3392
#define XCD_BAR_WORDS 3456
#define XB_SPIN_CAP (1u << 18)
#define LAS __attribute__((address_space(3)))
DI unsigned xb_ld(unsigned* p) { return __hip_atomic_load(p, __ATOMIC_RELAXED, __HIP_MEMORY_SCOPE_AGENT); }
DI unsigned xb_add(unsigned* p, unsigned v) { return __hip_atomic_fetch_add(p, v, __ATOMIC_RELAXED, __HIP_MEMORY_SCOPE_AGENT); }
DI unsigned xb_xcc_id() { return (unsigned)__builtin_amdgcn_s_getreg((3 << 11) | 20) & 0xFu; }
#define XB_SPIN(cond, bar) do { unsigned _sp = 0; while (cond) { __builtin_amdgcn_s_sleep(1); \
    if ((++_sp & 255u) == 0u) { if (xb_ld(&(bar)[XB_TMO])) break; if (_sp > XB_SPIN_CAP) { atomicAdd(&(bar)[XB_TMO], 1u); break; } } } } while (0)
struct XcdBarrier { unsigned* bar; unsigned x; volatile LAS unsigned* st; };
DI void xcd_barrier_complete(unsigned* bar, unsigned x, unsigned& nloc, unsigned& nx) {
    const unsigned G = gridDim.x * gridDim.y * gridDim.z;
    unsigned sum, cnt, mine, sp = 0u;
    for (;;) {
        sum = 0u; cnt = 0u; mine = 0u;
#pragma unroll
        for (unsigned j = 0; j < 16; ++j) { const unsigned c = xb_ld(&bar[XB_XCNT(j)]); sum += c; cnt += (c > 0u) ? 1u : 0u; mine = (j == x) ? c : mine; }
        if (sum == G) break;
        __builtin_amdgcn_s_sleep(1);
        if ((++sp & 255u) == 0u) { if (xb_ld(&bar[XB_TMO])) break; if (sp > XB_SPIN_CAP) { atomicAdd(&bar[XB_TMO], 1u); break; } }
    }
    nloc = mine > 0u ? mine : 1u; nx = cnt > 0u ? cnt : 1u;
}
DI void xcd_barrier(const XcdBarrier& b, const bool leader_thread) {
    asm volatile("s_waitcnt vmcnt(0)" ::: "memory");
    __syncthreads();
    if (leader_thread) {
        unsigned* bar = b.bar;
        __builtin_amdgcn_s_waitcnt(0);
        unsigned nloc = b.st[0], nx = b.st[1];
        if (nloc == 0u) { xcd_barrier_complete(bar, b.x, nloc, nx); b.st[0] = nloc; b.st[1] = nx; }
        const unsigned old = xb_add(&bar[XB_XSUB(b.x)], 1u);
        const unsigned gen = old / nloc;
        if (old + 1u == (gen + 1u) * nloc) {
            __builtin_amdgcn_fence(__ATOMIC_RELEASE, "agent");
            asm volatile("s_waitcnt vmcnt(0)" ::: "memory");
            const unsigned og = xb_add(&bar[XB_TOP], 1u);
            const unsigned tg = og / nx;
            if (og + 1u == (tg + 1u) * nx) xb_add(&bar[XB_TOPGEN], 1u);
            else XB_SPIN(xb_ld(&bar[XB_TOPGEN]) == tg, bar);
            __builtin_amdgcn_fence(__ATOMIC_ACQUIRE, "agent");
            xb_add(&bar[XB_XGEN(b.x)], 1u);
            asm volatile("s_waitcnt vmcnt(0)" ::: "memory");
        } else {
            XB_SPIN(xb_ld(&bar[XB_XGEN(b.x)]) == gen, bar);
            __builtin_amdgcn_fence(__ATOMIC_ACQUIRE, "agent");
            asm volatile("s_waitcnt vmcnt(0)" ::: "memory");
        }
    }
    __syncthreads();
}

constexpr int BM = 256, BK = 64, HALF = 128, HT = HALF * BK;
DI int lds_byte(int r, int c) {
    int st = (r >> 4) * 2 + (c >> 5), rr = r & 15, cc = c & 31, ob = rr * 64 + cc * 2;
    return st * 1024 + (ob ^ (((ob >> 9) & 1) << 5));
}
DI void stage_rc(int b, int& R, int& C) {
    int st = b / 1024, sb = b % 1024, swz = sb ^ (((sb >> 9) & 1) << 5);
    R = (st >> 1) * 16 + swz / 64; C = (st & 1) * 32 + (swz % 64) / 2;
}

enum { EPI_RESID = 0, EPI_RESID_ATOMIC, EPI_SWIGLU, EPI_PLAIN2, EPI_ROPE, EPI_MLA_DOWN, EPI_MLA_Q, EPI_MLA_K, EPI_VT };

struct GemmJob {
    const bf16_t* A; const bf16_t* B; int lda, ldb, M, N, K, epi;
    void* o0; void* o1; float* o2; const float* f0; const float* f1; int i0; float s0; int ksplit, row0;
};

DI void gemm_epilogue(const GemmJob& J, f32x4 (&acc)[2][2][4][2], int brow, int bcol, int wr, int wc, int fr, int fq, int ks) {
    const int epi = J.epi;
    if (epi == EPI_RESID) {
        const float* gp = J.f0 + (size_t)mod_row(brow) * 9216;
        const float cf = J.s0;
        f32x4 gv[2][2];
#pragma unroll
        for (int bj = 0; bj < 2; ++bj)
#pragma unroll
            for (int n = 0; n < 2; ++n) gv[bj][n] = *(const f32x4*)(gp + bcol + bj * HALF + wc * 32 + n * 16 + fq * 4) * cf;
#pragma unroll
        for (int ai = 0; ai < 2; ++ai) {
            f32x4 xv[4][2][2];
#pragma unroll
            for (int m = 0; m < 4; ++m) {
                const float* xp = (const float*)J.o0 + (size_t)(brow + ai * HALF + wr * 64 + m * 16 + fr) * DM + bcol + wc * 32 + fq * 4;
#pragma unroll
                for (int bj = 0; bj < 2; ++bj)
#pragma unroll
                    for (int n = 0; n < 2; ++n) xv[m][bj][n] = *(const f32x4*)(xp + bj * HALF + n * 16);
            }
            __builtin_amdgcn_sched_barrier(0);
#pragma unroll
            for (int m = 0; m < 4; ++m) {
                float* xp = (float*)J.o0 + (size_t)(brow + ai * HALF + wr * 64 + m * 16 + fr) * DM + bcol + wc * 32 + fq * 4;
#pragma unroll
                for (int bj = 0; bj < 2; ++bj)
#pragma unroll
                    for (int n = 0; n < 2; ++n) *(f32x4*)(xp + bj * HALF + n * 16) = xv[m][bj][n] + gv[bj][n] * acc[ai][bj][m][n];
            }
            __builtin_amdgcn_sched_barrier(0);
        }
        return;
    }
#pragma unroll
    for (int ai = 0; ai < 2; ++ai)
#pragma unroll
        for (int m = 0; m < 4; ++m) {
            const int row = brow + ai * HALF + wr * 64 + m * 16 + fr;
            if (epi == EPI_RESID) {
                const float* gp = J.f0 + (size_t)mod_row(row) * 9216;
                float* xp = (float*)J.o0 + (size_t)row * DM;
                const float cf = J.s0;
#pragma unroll
                for (int bj = 0; bj < 2; ++bj)
#pragma unroll
                    for (int n = 0; n < 2; ++n) {
                        const int col = bcol + bj * HALF + wc * 32 + n * 16 + fq * 4;
                        f32x4 g = *(const f32x4*)(gp + col);
                        f32x4 x = *(const f32x4*)(xp + col);
                        x += (g * cf) * acc[ai][bj][m][n];
                        *(f32x4*)(xp + col) = x;
                    }
            } else if (epi == EPI_RESID_ATOMIC) {
                const float* gp = J.f0 + (size_t)mod_row(row) * 9216;
                float* pp = J.o2 + ((size_t)ks * (MT - NLAT) + (row - NLAT)) * DM;
                const float cf = J.s0;
#pragma unroll
                for (int bj = 0; bj < 2; ++bj)
#pragma unroll
                    for (int n = 0; n < 2; ++n) {
                        const int col = bcol + bj * HALF + wc * 32 + n * 16 + fq * 4;
                        f32x4 g = *(const f32x4*)(gp + col);
                        *(f32x4*)(pp + col) = (g * cf) * acc[ai][bj][m][n];
                    }
            } else if (epi == EPI_SWIGLU) {
                bf16_t* op = (bf16_t*)J.o0 + (size_t)row * DFF + (bcol >> 1) + wc * 32 + fq * 8;
                f32x4 o0, o1;
#pragma unroll
                for (int j = 0; j < 4; ++j) { o0[j] = siluf(acc[ai][0][m][0][j]) * acc[ai][1][m][0][j]; o1[j] = siluf(acc[ai][0][m][1][j]) * acc[ai][1][m][1][j]; }
                u32x4 w; { const u32x2 a = pack4(o0), b = pack4(o1); w.x = a.x; w.y = a.y; w.z = b.x; w.w = b.y; }
                *(u32x4*)op = w;
            } else if (epi == EPI_PLAIN2) {
                bf16_t* q = (bf16_t*)J.o0 + (size_t)row * 1024;
                bf16_t* k = (bf16_t*)J.o1 + (size_t)row * 1024;
#pragma unroll
                for (int bj = 0; bj < 2; ++bj)
#pragma unroll
                    for (int n = 0; n < 2; ++n) {
                        const int col = bcol + bj * HALF + wc * 32 + n * 16 + fq * 4;
                        bf16_t* d = col < 1024 ? q + col : k + (col - 1024);
                        *(u32x2*)d = pack4(acc[ai][bj][m][n]);
                    }
            } else if (epi == EPI_ROPE) {
                const int NQH = J.i0, NKH = (J.N >> 6) - NQH;
                const bool latent = row < NLAT;
                const int pos = row & 4095;
#pragma unroll
                for (int bj = 0; bj < 2; ++bj) {
                    const int gcol = bcol + bj * HALF + wc * 32;
                    const int head64 = gcol >> 6, di = ((gcol >> 5) & 1) * 16 + fq * 4;
                    f32x4 v0 = acc[ai][bj][m][0], v1 = acc[ai][bj][m][1], r1 = v0, r2 = v1;
                    if (latent) {
                        f32x4 c4 = *(const f32x4*)(J.f0 + pos * 32 + di), s4 = *(const f32x4*)(J.f1 + pos * 32 + di);
                        r1 = v0 * c4 - v1 * s4; r2 = v0 * s4 + v1 * c4;
                    }
                    if (head64 < NQH) {
                        bf16_t* q = (bf16_t*)J.o0 + (size_t)row * (NQH * 128) + head64 * 128;
                        *(u32x2*)(q + 64 + di) = pack4(v0); *(u32x2*)(q + 96 + di) = pack4(v1);
                        *(u32x2*)(q + di) = pack4(r1); *(u32x2*)(q + 32 + di) = pack4(r2);
                    } else {
                        bf16_t* k = (bf16_t*)J.o1 + (size_t)row * (NKH * 64) + (head64 - NQH) * 64;
                        *(u32x2*)(k + di) = pack4(r1); *(u32x2*)(k + 32 + di) = pack4(r2);
                    }
                }
            } else if (epi == EPI_MLA_DOWN) {
                const int pn = bcol >> 8;
                if (pn < 3) {
                    bf16_t* d = (bf16_t*)J.o0 + (size_t)row * 1024;
                    float ss = 0.f;
#pragma unroll
                    for (int bj = 0; bj < 2; ++bj)
#pragma unroll
                        for (int n = 0; n < 2; ++n) {
                            const int col = bcol + bj * HALF + wc * 32 + n * 16 + fq * 4;
                            f32x4 v = acc[ai][bj][m][n];
                            ss += v[0] * v[0] + v[1] * v[1] + v[2] * v[2] + v[3] * v[3];
                            *(u32x2*)(d + col) = pack4(v);
                        }
                    ss += swz_xor<16>(ss); ss += bperm(ss, ((fq * 16 + fr) ^ 32) << 2);
                    if (fq == 0) J.o2[(size_t)row * 16 + pn * 4 + wc] = ss;
                } else if (wc < 2) {
                    const bool latent = row < NLAT;
                    const int pos = row & 4095, di = wc * 16 + fq * 4;
                    f32x4 v0 = acc[ai][0][m][0], v1 = acc[ai][0][m][1], r1 = v0, r2 = v1;
                    if (latent) {
                        f32x4 c4 = *(const f32x4*)(J.f0 + pos * 32 + di), s4 = *(const f32x4*)(J.f1 + pos * 32 + di);
                        r1 = v0 * c4 - v1 * s4; r2 = v0 * s4 + v1 * c4;
                    }
                    u32x2 p1 = pack4(r1), p2 = pack4(r2);
                    bf16_t* k = (bf16_t*)J.o1 + (size_t)row * 1536 + 128 + di;
#pragma unroll
                    for (int hh = 0; hh < 8; ++hh) { *(u32x2*)(k + hh * 192) = p1; *(u32x2*)(k + hh * 192 + 32) = p2; }
                }
            } else if (epi == EPI_MLA_Q) {
                const float* sp = J.f0 + (size_t)row * 16;
                f32x4 a = *(const f32x4*)sp, b = *(const f32x4*)(sp + 4);
                const float rstd = rsqrtf((a[0] + a[1] + a[2] + a[3] + b[0] + b[1] + b[2] + b[3]) * (1.0f / 512.0f) + EPSV);
                const bool latent = row < NLAT;
                const int pos = row & 4095;
                const float* cosT = (const float*)J.o1; const float* sinT = J.f1;
#pragma unroll
                for (int bj = 0; bj < 2; ++bj) {
                    const int g = (bcol + bj * HALF + wc * 32) >> 5;
                    const int head = g / 6, gi = g - head * 6;
                    bf16_t* q = (bf16_t*)J.o0 + (size_t)row * 2048 + head * 256;
                    f32x4 v0 = acc[ai][bj][m][0] * rstd, v1 = acc[ai][bj][m][1] * rstd;
                    if (gi < 4) {
                        *(u32x2*)(q + gi * 32 + fq * 4) = pack4(v0); *(u32x2*)(q + gi * 32 + 16 + fq * 4) = pack4(v1);
                    } else {
                        const int di = (gi - 4) * 16 + fq * 4;
                        *(u32x2*)(q + 192 + di) = pack4(v0); *(u32x2*)(q + 224 + di) = pack4(v1);
                        if (latent) {
                            f32x4 c4 = *(const f32x4*)(cosT + pos * 32 + di), s4 = *(const f32x4*)(sinT + pos * 32 + di);
                            *(u32x2*)(q + 128 + di) = pack4(v0 * c4 - v1 * s4); *(u32x2*)(q + 160 + di) = pack4(v0 * s4 + v1 * c4);
                        }
                    }
                }
            } else if (epi == EPI_MLA_K) {
                f32x4 a = *(const f32x4*)(J.f0 + (size_t)row * 16 + 8);
                const float rstd = rsqrtf((a[0] + a[1] + a[2] + a[3]) * (1.0f / 256.0f) + EPSV);
                bf16_t* k = (bf16_t*)J.o0 + (size_t)row * 1536;
#pragma unroll
                for (int bj = 0; bj < 2; ++bj)
#pragma unroll
                    for (int n = 0; n < 2; ++n) {
                        const int col = bcol + bj * HALF + wc * 32 + n * 16 + fq * 4;
                        *(u32x2*)(k + (col >> 7) * 192 + (col & 127)) = pack4(acc[ai][bj][m][n] * rstd);
                    }
            } else {
                bf16_t* vt = (bf16_t*)J.o0 + (size_t)row * MT;
#pragma unroll
                for (int bj = 0; bj < 2; ++bj)
#pragma unroll
                    for (int n = 0; n < 2; ++n) {
                        const int col = bcol + bj * HALF + wc * 32 + n * 16 + fq * 4;
                        f32x4 v = acc[ai][bj][m][n];
                        if (J.i0) {
#pragma unroll
                            for (int j = 0; j < 4; ++j) {
                                f32x4 a = *(const f32x4*)(J.f0 + (size_t)(col + j) * 16 + 8);
                                v[j] *= rsqrtf((a[0] + a[1] + a[2] + a[3]) * (1.0f / 256.0f) + EPSV);
                            }
                        }
                        *(u32x2*)(vt + col) = pack4(v);
                    }
            }
            __builtin_amdgcn_sched_barrier(0);
        }
}

DI void gemm_run(const GemmJob& J, char* lds, const int tid_in, const int rot) {
    bf16_t* shm = (bf16_t*)lds;
    const int lda = J.lda, ldb = J.ldb, ksplit = J.ksplit;
    const __amdgpu_buffer_rsrc_t rs_A = __builtin_amdgcn_make_buffer_rsrc((void*)J.A, 0, 0x7fffffff, 0x00020000);
    const __amdgpu_buffer_rsrc_t rs_Bt = __builtin_amdgcn_make_buffer_rsrc((void*)J.B, 0, 0x7fffffff, 0x00020000);
#define SA(b, h) (shm + ((b) * 2 + (h)) * HT)
#define SB(b, h) (shm + (4 + (b) * 2 + (h)) * HT)
#define STAGE(P, BASE, OFF, LD, br, kt) do { const int _so = ((br) * (LD) + (kt) * BK) * 2 + kbyte; \
    for (int _i = 0; _i < 2; ++_i) { \
      __builtin_amdgcn_raw_ptr_buffer_load_lds(rs_##BASE, \
        (__attribute__((address_space(3))) unsigned*)((char*)(P) + tid_in * 1024 + _i * 8192), 16, OFF[_i], _so, 0, 0); } } while (0)
#define LDA(dst, b, h) for (int m = 0; m < 4; ++m) for (int k = 0; k < 2; ++k) \
    dst[m][k] = *reinterpret_cast<const bf16x8*>((char*)SA(b, h) + lds_byte(wr * 64 + m * 16 + fr, k * 32 + fq * 8))
#define LDB(dst, b, h) for (int n = 0; n < 2; ++n) for (int k = 0; k < 2; ++k) \
    dst[n][k] = *reinterpret_cast<const bf16x8*>((char*)SB(b, h) + lds_byte(wc * 32 + n * 16 + fr, k * 32 + fq * 8))
#define MMA(ai, bj, At_, Bt_) do { __builtin_amdgcn_s_setprio(1); \
    for (int m = 0; m < 4; ++m) for (int n = 0; n < 2; ++n) for (int k = 0; k < 2; ++k) \
      acc[ai][bj][m][n] = __builtin_amdgcn_mfma_f32_16x16x32_bf16(Bt_[n][k], At_[m][k], acc[ai][bj][m][n], 0, 0, 0); \
    __builtin_amdgcn_s_setprio(0); } while (0)
#define WAIT_V(n) asm volatile("s_waitcnt vmcnt(" #n ")" ::: "memory")
#define WAIT_L(n) asm volatile("s_waitcnt lgkmcnt(" #n ")" ::: "memory")
#define BAR __builtin_amdgcn_s_barrier()
#define SCHED __builtin_amdgcn_sched_barrier(0)
    const int nM = J.M / BM, nN = J.N / BM, nwg = nM * nN * J.ksplit;
    const int nt = J.K / J.ksplit / BK;
    for (int it = 0;; ++it) {
        int cshift = (int)blockIdx.x - rot; if (cshift < 0) cshift += gridDim.x;
        const long L = (long)it * gridDim.x + cshift;
        if (L >= nwg) break;
        const int tid = fresh_tid(tid_in);
        const int wid = tid >> 6, lane = tid & 63, wr = wid >> 2, wc = wid & 3, fr = lane & 15, fq = lane >> 4;
        unsigned offA[2], offB[2];
#pragma unroll
        for (int i = 0; i < 2; ++i) { int r_, c_; stage_rc(tid * 16 + i * 8192, r_, c_); offA[i] = (unsigned)(r_ * lda + c_) * 2u; offB[i] = (unsigned)(r_ * ldb + c_) * 2u; }
        int pm, pn, kbyte = 0, ksel = 0;
        if (ksplit > 1) {
            const int tile = (int)L / ksplit, ks = (int)L % ksplit; ksel = ks;
            pm = tile % nM; pn = tile / nM;
            kbyte = ks * (J.K / ksplit) * 2;
        } else {
            int wgid = (int)L;
            { const int q = nwg / 8, r = nwg % 8, xcd = wgid % 8, off = wgid / 8; wgid = (xcd < r ? xcd * (q + 1) : r * (q + 1) + (xcd - r) * q) + off; }
            const int nig = 8 * nN, gid = wgid / nig, fm = gid * 8, gsz = (nM - fm) < 8 ? (nM - fm) : 8;
            pm = fm + ((wgid % nig) % gsz); pn = (wgid % nig) / gsz;
        }
        const int brow = pm * BM, bcol = pn * BM;
        f32x4 acc[2][2][4][2];
#pragma unroll
        for (int a = 0; a < 2; ++a)
#pragma unroll
            for (int b = 0; b < 2; ++b)
#pragma unroll
                for (int m = 0; m < 4; ++m)
#pragma unroll
                    for (int n = 0; n < 2; ++n) acc[a][b][m][n] = (f32x4){0.f, 0.f, 0.f, 0.f};
        bf16x8 At[4][2], B0[2][2], B1[2][2];
        WAIT_V(0);
        STAGE(SB(0, 0), Bt, offB, ldb, bcol, 0); STAGE(SA(0, 0), A, offA, lda, brow, 0);
        STAGE(SB(0, 1), Bt, offB, ldb, bcol + HALF, 0); STAGE(SA(0, 1), A, offA, lda, brow + HALF, 0);
        if (wr == 1) BAR;
        WAIT_V(4); BAR;
        STAGE(SB(1, 0), Bt, offB, ldb, bcol, 1); STAGE(SA(1, 0), A, offA, lda, brow, 1); STAGE(SB(1, 1), Bt, offB, ldb, bcol + HALF, 1);
        WAIT_V(6); BAR;
        for (int t = 0; t < nt - 2; t += 2) {
            LDB(B0, 0, 0); SCHED; LDA(At, 0, 0); STAGE(SA(1, 1), A, offA, lda, brow + HALF, t + 1);
            WAIT_L(8); BAR; WAIT_L(0); MMA(0, 0, At, B0); BAR; SCHED;
            LDB(B1, 0, 1); STAGE(SB(0, 0), Bt, offB, ldb, bcol, t + 2);
            BAR; WAIT_L(0); MMA(0, 1, At, B1); BAR;
            LDA(At, 0, 1); STAGE(SA(0, 0), A, offA, lda, brow, t + 2);
            BAR; WAIT_L(0); MMA(1, 0, At, B0); BAR; SCHED;
            STAGE(SB(0, 1), Bt, offB, ldb, bcol + HALF, t + 2);
            WAIT_V(6); BAR; MMA(1, 1, At, B1); BAR;
            LDB(B0, 1, 0); SCHED; LDA(At, 1, 0); STAGE(SA(0, 1), A, offA, lda, brow + HALF, t + 2);
            WAIT_L(8); BAR; WAIT_L(0); MMA(0, 0, At, B0); BAR; SCHED;
            LDB(B1, 1, 1); STAGE(SB(1, 0), Bt, offB, ldb, bcol, t + 3);
            BAR; WAIT_L(0); MMA(0, 1, At, B1); BAR;
            LDA(At, 1, 1); STAGE(SA(1, 0), A, offA, lda, brow, t + 3);
            BAR; WAIT_L(0); MMA(1, 0, At, B0); BAR; SCHED;
            STAGE(SB(1, 1), Bt, offB, ldb, bcol + HALF, t + 3);
            WAIT_V(6); BAR; MMA(1, 1, At, B1); BAR;
        }
        { LDB(B0, 0, 0); LDA(At, 0, 0); STAGE(SA(1, 1), A, offA, lda, brow + HALF, nt - 1);
          BAR; WAIT_L(0); MMA(0, 0, At, B0); BAR;
          LDB(B1, 0, 1); BAR; WAIT_L(0); MMA(0, 1, At, B1); BAR;
          LDA(At, 0, 1); WAIT_V(4); BAR; WAIT_L(0); MMA(1, 0, At, B0); MMA(1, 1, At, B1); BAR; }
        { LDB(B0, 1, 0); LDA(At, 1, 0); WAIT_V(2); BAR; WAIT_L(0); MMA(0, 0, At, B0); BAR;
          LDB(B1, 1, 1); WAIT_V(0); BAR; WAIT_L(0); MMA(0, 1, At, B1); BAR;
          LDA(At, 1, 1); BAR; WAIT_L(0); MMA(1, 0, At, B0); MMA(1, 1, At, B1); BAR; }
        if (wr == 0) BAR;
        { const int tid2 = fresh_tid(tid_in);
          const int wid2 = tid2 >> 6, lane2 = tid2 & 63;
          gemm_epilogue(J, acc, brow + J.row0, bcol, wid2 >> 2, wid2 & 3, lane2 & 15, lane2 >> 4, ksel); }
    }
#undef SA
#undef SB
}

struct AttnArgs {
    const bf16_t* q; int q_ts, q_hs, q_rot, q_plain;
    const bf16_t* k; int k_ts, k_hs;
    const bf16_t* vt; bf16_t* ao;
    int NH; int ctx_units; float scale;
    const float* sink; const float* rpb; const float* lamp; const float* ng; float lam_init;
};

DI int crow(int i, int h) { return (i & 3) + 8 * (i >> 2) + 4 * h; }

template <int DQK, int DV, int MODE, bool PAIR>
DI void attn_phase(const AttnArgs& a, char* lds, const int tid) {
    constexpr int KW = PAIR ? 128 : DQK;
    constexpr int KST = KW * 2 + 16;
    constexpr int VST = 136;
    constexpr int KBYTES = 64 * KST, VBYTES = DV * VST, BUF = KBYTES + VBYTES;
    constexpr int QB = PAIR ? 128 : 256;
    constexpr int NQB = 4096 / QB;
    constexpr int NS = DQK / 16, NDB = DV / 32;
    constexpr int KCH = (64 * KW * 2 / 16) / NTHREADS;
    constexpr int VCH = (DV * 128 / 16) / NTHREADS;
    constexpr int NOPE = DQK - 64;
    static_assert(2 * BUF <= 120 * 1024, "lds");
    const int wave = tid >> 6, lane = tid & 63, r = lane & 31, h = lane >> 5;
    const int x32 = (lane ^ 32) << 2;
    const int wq = PAIR ? (wave & 3) : wave, gsel = PAIR ? (wave >> 2) : 0;
    const int koff = gsel * 64;
    const float cs = a.scale * LOG2E;
    float* rpbL = (float*)(lds + 122880);
    const int n_lat = 4 * a.NH * NQB;
    const int n_units = n_lat + (a.ctx_units ? 4 * a.NH : 0);
    float lam = 0.f;
    if (PAIR) {
        float p0 = a.lamp[lane] * a.lamp[64 + lane], p1 = a.lamp[128 + lane] * a.lamp[192 + lane];
        p0 = wave_sum(p0, lane); p1 = wave_sum(p1, lane);
        lam = __expf(p0) - __expf(p1) + a.lam_init;
    }
    for (int u = blockIdx.x; u < n_units; u += gridDim.x) {
        const bool isctx = u >= n_lat;
        int b, hh, qb;
        if (!isctx) { qb = u % NQB; hh = (u / NQB) % a.NH; b = u / (NQB * a.NH); }
        else { const int v = u - n_lat; qb = 0; hh = v % a.NH; b = v / a.NH; }
        const int tokq0 = isctx ? (NLAT + b * 256) : (b * 4096 + qb * QB);
        const int tokq = tokq0 + wq * 32 + r;
        const int qhead = PAIR ? 2 * hh + gsel : hh;
        const int kvhead = (MODE == 1) ? (hh >> 2) : hh;
        const bf16_t* qp = a.q + (size_t)tokq * a.q_ts + qhead * a.q_hs;
        const bf16_t* kbase = a.k + kvhead * a.k_hs;
        const bf16_t* vbase = a.vt + (size_t)(kvhead * DV) * MT;
        int tlo = 0, thi = 0;
        if (!isctx) {
            if (MODE == 0) { tlo = 0; thi = 64; }
            else if (MODE == 1) { const int q0 = qb * QB; tlo = (q0 - 128) < 0 ? 0 : (q0 - 128) >> 6; thi = (q0 + QB + 128) >> 6; if (thi > 64) thi = 64; }
            else { const int r0 = qb * 4; int lo = r0 - 4; lo = lo < 0 ? 0 : (lo > 56 ? 56 : lo); int hi2 = r0 + 3 - 4; hi2 = hi2 < 0 ? 0 : (hi2 > 56 ? 56 : hi2); tlo = lo; thi = hi2 + 8; }
        }
        const int T = 4 + (thi - tlo);
        if (MODE == 2) {
            for (int i = tid; i < 465; i += NTHREADS) rpbL[i] = a.rpb[hh * 465 + i];
        }
        const int qpos = qb * QB + wq * 32 + r;
        const int qrow = qpos >> 6, qcol = qpos & 63;
        int cstart = qcol - 8; cstart = cstart < 0 ? 0 : (cstart > 48 ? 48 : cstart);
        int rstart = qrow - 4; rstart = rstart < 0 ? 0 : (rstart > 56 ? 56 : rstart);

        constexpr bool D2 = (KCH + VCH) <= 4;
        constexpr int NSET = D2 ? 2 : 1;
        u32x4 kreg[NSET][KCH], vreg[NSET][VCH];
        const __amdgpu_buffer_rsrc_t rs_k = __builtin_amdgcn_make_buffer_rsrc((void*)kbase, 0, 0x7fffffff, 0x00020000);
        const __amdgpu_buffer_rsrc_t rs_v = __builtin_amdgcn_make_buffer_rsrc((void*)vbase, 0, 0x7fffffff, 0x00020000);
        auto tile_tok = [&](int t) { return t < 4 ? (NLAT + b * 256 + t * 64) : (b * 4096 + (tlo + t - 4) * 64); };
        auto load_tile = [&](int t, const int set) __attribute__((always_inline)) {
            const int tok = tile_tok(t);
#pragma unroll
            for (int c = 0; c < KCH; ++c) { const int idx = tid + c * NTHREADS, row = idx / (KW / 8), ch = idx % (KW / 8);
                kreg[set][c] = __builtin_amdgcn_raw_buffer_load_b128(rs_k, (row * a.k_ts + ch * 8) * 2, tok * a.k_ts * 2, 0); }
#pragma unroll
            for (int c = 0; c < VCH; ++c) { const int idx = tid + c * NTHREADS, row = idx >> 3, ch = idx & 7;
                vreg[set][c] = __builtin_amdgcn_raw_buffer_load_b128(rs_v, (row * MT + ch * 8) * 2, tok * 2, 0); }
        };
        auto store_tile = [&](int buf, const int set) __attribute__((always_inline)) {
            char* kb = lds + buf * BUF; char* vb = kb + KBYTES;
#pragma unroll
            for (int c = 0; c < KCH; ++c) { const int idx = tid + c * NTHREADS, row = idx / (KW / 8), ch = idx % (KW / 8);
                *(u32x4*)(kb + row * KST + ch * 16) = kreg[set][c]; }
#pragma unroll
            for (int c = 0; c < VCH; ++c) { const int idx = tid + c * NTHREADS, row = idx >> 3, ch = idx & 7;
                u32x2 w0 = {vreg[set][c].x, vreg[set][c].y}, w1 = {vreg[set][c].z, vreg[set][c].w};
                *(u32x2*)(vb + row * VST + ch * 16) = w0; *(u32x2*)(vb + row * VST + ch * 16 + 8) = w1; }
        };
        bf16x8 qf[NS];
        auto load_q = [&](bool lat) {
#pragma unroll
            for (int s = 0; s < NS; ++s) {
                const int off = (s * 16 < NOPE) ? s * 16 : ((lat ? a.q_rot : a.q_plain) + s * 16 - NOPE);
                qf[s] = *(const bf16x8*)(qp + off + 8 * h);
            }
        };
        f32x16 ot[NDB];
#pragma unroll
        for (int d = 0; d < NDB; ++d)
#pragma unroll
            for (int i = 0; i < 16; ++i) ot[d][i] = 0.f;
        float m_run = -1e30f, l_run = 0.f;

        load_tile(0, 0); store_tile(0, 0);
        if (D2) load_tile(T > 1 ? 1 : 0, 1);
        load_q(false);
        __syncthreads();
        auto tile_body = [&](const int t, const bool LAT, const int PAR) __attribute__((always_inline)) {
            if (D2) load_tile(t + 2 < T ? t + 2 : T - 1, PAR);
            else load_tile(t + 1 < T ? t + 1 : T - 1, 0);
            const char* kb_l = lds + (t & 1) * BUF; const char* vb_l = kb_l + KBYTES;
            bool skip = false;
            const int kt = tlo + t - 4;
            if (LAT) {
                if (MODE == 1) { const int ts = kt * 64, qw = qb * QB + wq * 32; skip = (ts + 63 < qw - 128) || (ts > qw + 31 + 128); }
                if (MODE == 2) { skip = (kt < rstart) || (kt >= rstart + 8); }
            }
            if (!skip) {
              if constexpr (DQK == 64) {
                constexpr int G = (NS <= 4) ? NS : 6;
                constexpr bool VBOTH = (DV == 64);
                f32x16 st[2];
#pragma unroll
                for (int i = 0; i < 16; ++i) { st[0][i] = 0.f; st[1][i] = 0.f; }
#pragma unroll
                for (int g0 = 0; g0 < NS; g0 += G) {
                    bf16x8 ka[G], kc[G];
#pragma unroll
                    for (int s = 0; s < G; ++s) {
                        ka[s] = *(const bf16x8*)(kb_l + r * KST + (koff + 8 * h) * 2 + (g0 + s) * 32);
                        kc[s] = *(const bf16x8*)(kb_l + (32 + r) * KST + (koff + 8 * h) * 2 + (g0 + s) * 32);
                    }
                    __builtin_amdgcn_sched_barrier(0);
#pragma unroll
                    for (int s = 0; s < G; ++s) {
                        st[0] = __builtin_amdgcn_mfma_f32_32x32x16_bf16(ka[s], qf[g0 + s], st[0], 0, 0, 0);
                        st[1] = __builtin_amdgcn_mfma_f32_32x32x16_bf16(kc[s], qf[g0 + s], st[1], 0, 0, 0);
                    }
                }
                s16x4 vlo[VBOTH ? 2 : 1][2][NDB], vhi[VBOTH ? 2 : 1][2][NDB];
#pragma unroll
                for (int kb = 0; kb < (VBOTH ? 2 : 1); ++kb)
#pragma unroll
                    for (int s2 = 0; s2 < 2; ++s2)
#pragma unroll
                        for (int d = 0; d < NDB; ++d) {
                            const char* vp = vb_l + (32 * d + r) * VST + (32 * kb + 16 * s2 + 4 * h) * 2;
                            vlo[kb][s2][d] = *(const s16x4*)vp; vhi[kb][s2][d] = *(const s16x4*)(vp + 16);
                        }
                __builtin_amdgcn_sched_barrier(0);
                const bool MASKED = (MODE != 0) && LAT;
                float mx = -3e38f;
                if (MASKED) {
#pragma unroll
                    for (int kb = 0; kb < 2; ++kb)
#pragma unroll
                        for (int i = 0; i < 16; ++i) {
                            float tv = st[kb][i] * cs;
                            if (MODE == 1) {
                                const int d = kt * 64 + 32 * kb + crow(i, h) - qpos; const bool valid = (d <= 128) && (d >= -128); tv = valid ? tv : -1e30f;
                            } else if (MODE == 2) {
                                const int kc2 = 32 * kb + crow(i, h);
                                const bool valid = (kc2 >= cstart) && (kc2 < cstart + 16);
                                int bi = (kt - qrow + 7) * 31 + (kc2 - qcol + 15); bi = valid ? bi : 0;
                                const float bias = rpbL[bi];
                                tv = valid ? (tv + bias * LOG2E) : -1e30f;
                            }
                            st[kb][i] = tv; mx = fmaxf(mx, tv);
                        }
                } else {
#pragma unroll
                    for (int kb = 0; kb < 2; ++kb)
#pragma unroll
                        for (int i = 0; i < 16; ++i) mx = fmaxf(mx, st[kb][i]);
                    mx *= cs;
                }
                mx = fmaxf(mx, bperm(mx, x32));
                if (__any(mx - m_run > RESCALE_THR)) {
                    const float m_up = fmaxf(m_run, mx);
                    const float alpha = fexp2(m_run - m_up);
                    l_run *= alpha;
#pragma unroll
                    for (int d = 0; d < NDB; ++d)
#pragma unroll
                        for (int i = 0; i < 16; ++i) ot[d][i] *= alpha;
                    m_run = m_up;
                }
                const float m_new = m_run;
                float rs = 0.f;
#pragma unroll
                for (int kb = 0; kb < 2; ++kb)
#pragma unroll
                    for (int i = 0; i < 16; ++i) {
                        const float p = MASKED ? fexp2(st[kb][i] - m_new) : fexp2(__builtin_fmaf(st[kb][i], cs, -m_new));
                        st[kb][i] = p; rs += p;
                    }
                l_run += rs;
#pragma unroll
                for (int kb = 0; kb < 2; ++kb) {
                    if (!VBOTH && kb == 1) {
#pragma unroll
                        for (int s2 = 0; s2 < 2; ++s2)
#pragma unroll
                            for (int d = 0; d < NDB; ++d) {
                                const char* vp = vb_l + (32 * d + r) * VST + (32 + 16 * s2 + 4 * h) * 2;
                                vlo[0][s2][d] = *(const s16x4*)vp; vhi[0][s2][d] = *(const s16x4*)(vp + 16);
                            }
                    }
                    const int vs = VBOTH ? kb : 0;
#pragma unroll
                    for (int s2 = 0; s2 < 2; ++s2) {
                        u32x4 pw;
                        pw.x = pack2(st[kb][8 * s2 + 0], st[kb][8 * s2 + 1]); pw.y = pack2(st[kb][8 * s2 + 2], st[kb][8 * s2 + 3]);
                        pw.z = pack2(st[kb][8 * s2 + 4], st[kb][8 * s2 + 5]); pw.w = pack2(st[kb][8 * s2 + 6], st[kb][8 * s2 + 7]);
                        const bf16x8 pf = __builtin_bit_cast(bf16x8, pw);
#pragma unroll
                        for (int d = 0; d < NDB; ++d) {
                            const bf16x8 vf = __builtin_shufflevector(vlo[vs][s2][d], vhi[vs][s2][d], 0, 1, 2, 3, 4, 5, 6, 7);
                            ot[d] = __builtin_amdgcn_mfma_f32_32x32x16_bf16(vf, pf, ot[d], 0, 0, 0);
                        }
                    }
                }
              } else {
                constexpr bool PREK = NS <= 4;
                bf16x8 kf[NS];
#pragma unroll
                for (int s = 0; s < NS; ++s) kf[s] = *(const bf16x8*)(kb_l + r * KST + (koff + 8 * h) * 2 + s * 32);
#pragma unroll
                for (int kb = 0; kb < 2; ++kb) {
                    f32x16 st;
#pragma unroll
                    for (int i = 0; i < 16; ++i) st[i] = 0.f;
                    __builtin_amdgcn_sched_barrier(0);
#pragma unroll
                    for (int s = 0; s < NS; ++s) st = __builtin_amdgcn_mfma_f32_32x32x16_bf16(kf[s], qf[s], st, 0, 0, 0);
                    s16x4 vlo[2][NDB], vhi[2][NDB];
#pragma unroll
                    for (int s2 = 0; s2 < 2; ++s2)
#pragma unroll
                        for (int d = 0; d < NDB; ++d) {
                            const char* vp = vb_l + (32 * d + r) * VST + (32 * kb + 16 * s2 + 4 * h) * 2;
                            vlo[s2][d] = *(const s16x4*)vp; vhi[s2][d] = *(const s16x4*)(vp + 16);
                        }
                    if (kb == 0) {
                        if (PREK) {
#pragma unroll
                            for (int s = 0; s < NS; ++s) kf[s] = *(const bf16x8*)(kb_l + (32 + r) * KST + (koff + 8 * h) * 2 + s * 32);
                        }
                    }
                    __builtin_amdgcn_sched_barrier(0);
                    const bool MASKED = (MODE != 0) && LAT;
                    float mx = -3e38f;
                    if (MASKED) {
#pragma unroll
                        for (int i = 0; i < 16; ++i) {
                            float tv = st[i] * cs;
                            if (MODE == 1) {
                                const int d = kt * 64 + 32 * kb + crow(i, h) - qpos; const bool valid = (d <= 128) && (d >= -128); tv = valid ? tv : -1e30f;
                            } else if (MODE == 2) {
                                const int kc = 32 * kb + crow(i, h);
                                const bool valid = (kc >= cstart) && (kc < cstart + 16);
                                int bi = (kt - qrow + 7) * 31 + (kc - qcol + 15); bi = valid ? bi : 0;
                                const float bias = rpbL[bi];
                                tv = valid ? (tv + bias * LOG2E) : -1e30f;
                            }
                            st[i] = tv; mx = fmaxf(mx, tv);
                        }
                    } else {
#pragma unroll
                        for (int i = 0; i < 16; ++i) mx = fmaxf(mx, st[i]);
                        mx *= cs;
                    }
                    mx = fmaxf(mx, bperm(mx, x32));
                    if (__any(mx - m_run > RESCALE_THR)) {
                        const float m_up = fmaxf(m_run, mx);
                        const float alpha = fexp2(m_run - m_up);
                        l_run *= alpha;
#pragma unroll
                        for (int d = 0; d < NDB; ++d)
#pragma unroll
                            for (int i = 0; i < 16; ++i) ot[d][i] *= alpha;
                        m_run = m_up;
                    }
                    const float m_new = m_run;
                    float rs = 0.f;
                    if (MASKED) {
#pragma unroll
                        for (int i = 0; i < 16; ++i) { const float p = fexp2(st[i] - m_new); st[i] = p; rs += p; }
                    } else {
#pragma unroll
                        for (int i = 0; i < 16; ++i) { const float p = fexp2(__builtin_fmaf(st[i], cs, -m_new)); st[i] = p; rs += p; }
                    }
                    l_run += rs;
#pragma unroll
                    for (int s2 = 0; s2 < 2; ++s2) {
                        u32x4 pw;
                        pw.x = pack2(st[8 * s2 + 0], st[8 * s2 + 1]); pw.y = pack2(st[8 * s2 + 2], st[8 * s2 + 3]);
                        pw.z = pack2(st[8 * s2 + 4], st[8 * s2 + 5]); pw.w = pack2(st[8 * s2 + 6], st[8 * s2 + 7]);
                        const bf16x8 pf = __builtin_bit_cast(bf16x8, pw);
#pragma unroll
                        for (int d = 0; d < NDB; ++d) {
                            const bf16x8 vf = __builtin_shufflevector(vlo[s2][d], vhi[s2][d], 0, 1, 2, 3, 4, 5, 6, 7);
                            ot[d] = __builtin_amdgcn_mfma_f32_32x32x16_bf16(vf, pf, ot[d], 0, 0, 0);
                        }
                    }
                    if (kb == 0) {
                        if (!PREK) {
#pragma unroll
                            for (int s = 0; s < NS; ++s) kf[s] = *(const bf16x8*)(kb_l + (32 + r) * KST + (koff + 8 * h) * 2 + s * 32);
                        }
                    }
                }
              }
            }
            store_tile((t + 1) & 1, D2 ? (PAR ^ 1) : 0);
            __syncthreads();
        };
        for (int t = 0; t < 4; t += 2) { tile_body(t, false, 0); tile_body(t + 1, false, 1); }
        if (T > 4) {
            load_q(true);
            for (int t = 4; t < T; t += 2) { tile_body(t, true, 0); if (t + 1 < T) tile_body(t + 1, true, 1); }
        }
        float l_tot = l_run + bperm(l_run, x32);
        if (MODE == 1) l_tot += fexp2(a.sink[hh] * LOG2E - m_run);
        const float inv = 1.0f / l_tot;
        if (!PAIR) {
            bf16_t* op = a.ao + (size_t)tokq * 1024 + hh * DV;
#pragma unroll
            for (int d = 0; d < NDB; ++d)
#pragma unroll
                for (int g = 0; g < 4; ++g) {
                    f32x4 v = {ot[d][4 * g] * inv, ot[d][4 * g + 1] * inv, ot[d][4 * g + 2] * inv, ot[d][4 * g + 3] * inv};
                    *(u32x2*)(op + 32 * d + 8 * g + 4 * h) = pack4(v);
                }
        } else {
            float* ex = (float*)lds;
            if (gsel == 1) {
#pragma unroll
                for (int d = 0; d < NDB; ++d)
#pragma unroll
                    for (int i = 0; i < 16; ++i) ex[(wq * 128 + 32 * d + crow(i, h)) * 32 + r] = ot[d][i] * inv;
            }
            __syncthreads();
            if (gsel == 0) {
                float ss = 0.f;
#pragma unroll
                for (int d = 0; d < NDB; ++d)
#pragma unroll
                    for (int i = 0; i < 16; ++i) {
                        const float o1 = ex[(wq * 128 + 32 * d + crow(i, h)) * 32 + r];
                        const float v = ot[d][i] * inv - lam * o1;
                        ot[d][i] = v; ss += v * v;
                    }
                ss += bperm(ss, x32);
                const float rstd = rsqrtf(ss * (1.0f / 128.0f) + EPSV) * (1.0f - a.lam_init);
                bf16_t* op = a.ao + (size_t)tokq * 1024 + hh * DV;
#pragma unroll
                for (int d = 0; d < NDB; ++d)
#pragma unroll
                    for (int g = 0; g < 4; ++g) {
                        const int dd = 32 * d + 8 * g + 4 * h;
                        f32x4 gn = *(const f32x4*)(a.ng + dd);
                        f32x4 v = {ot[d][4 * g] * rstd * gn[0], ot[d][4 * g + 1] * rstd * gn[1], ot[d][4 * g + 2] * rstd * gn[2], ot[d][4 * g + 3] * rstd * gn[3]};
                        *(u32x2*)(op + dd) = pack4(v);
                    }
            }
            __syncthreads();
        }
    }
}

DI void norm_phase(float* X, const float* g, const float* mods_l, int shift_i, int scale_i, bf16_t* H, int nrows, const int tid, const float* part, int npart) {
    const int wave = tid >> 6, lane = tid & 63;
    const int gw = blockIdx.x * 8 + wave, nw = gridDim.x * 8;
    for (int row = gw; row < nrows; row += nw) {
        float* xp = X + (size_t)row * DM;
        f32x4 v[4]; float ss = 0.f;
#pragma unroll
        for (int i = 0; i < 4; ++i) v[i] = *(const f32x4*)(xp + i * 256 + lane * 4);
        if (row >= NLAT && npart > 0) {
            for (int sidx = 0; sidx < npart; ++sidx) {
                const float* pp = part + ((size_t)sidx * (MT - NLAT) + (row - NLAT)) * DM;
#pragma unroll
                for (int i = 0; i < 4; ++i) v[i] += *(const f32x4*)(pp + i * 256 + lane * 4);
            }
#pragma unroll
            for (int i = 0; i < 4; ++i) *(f32x4*)(xp + i * 256 + lane * 4) = v[i];
        }
#pragma unroll
        for (int i = 0; i < 4; ++i) ss += v[i][0] * v[i][0] + v[i][1] * v[i][1] + v[i][2] * v[i][2] + v[i][3] * v[i][3];
        ss = wave_sum(ss, lane);
        const float rstd = rsqrtf(ss * (1.0f / 1024.0f) + EPSV);
        const float* mp = mods_l + (size_t)mod_row(row) * 9216;
#pragma unroll
        for (int i = 0; i < 4; ++i) {
            const int col = i * 256 + lane * 4;
            f32x4 gg = *(const f32x4*)(g + col), sh = *(const f32x4*)(mp + shift_i * 1024 + col), sc = *(const f32x4*)(mp + scale_i * 1024 + col);
            f32x4 y = (v[i] * rstd) * gg;
            y = y * (sc + 1.0f) + sh;
            *(u32x2*)(H + (size_t)row * DM + col) = pack4(y);
        }
    }
}

DI void final_phase(const float* X, const float* g, float* out, const int tid) {
    const int wave = tid >> 6, lane = tid & 63;
    const int gw = blockIdx.x * 8 + wave, nw = gridDim.x * 8;
    for (int row = gw; row < NLAT; row += nw) {
        const float* xp = X + (size_t)row * DM;
        f32x4 v[4]; float ss = 0.f;
#pragma unroll
        for (int i = 0; i < 4; ++i) { v[i] = *(const f32x4*)(xp + i * 256 + lane * 4); ss += v[i][0] * v[i][0] + v[i][1] * v[i][1] + v[i][2] * v[i][2] + v[i][3] * v[i][3]; }
        ss = wave_sum(ss, lane);
        const float rstd = rsqrtf(ss * (1.0f / 1024.0f) + EPSV);
#pragma unroll
        for (int i = 0; i < 4; ++i) {
            const int col = i * 256 + lane * 4;
            f32x4 gg = *(const f32x4*)(g + col);
            *(f32x4*)(out + (size_t)row * DM + col) = (v[i] * rstd) * gg;
        }
    }
}

struct ConvJob { const float* src; int srcN, K, dstN, mode, coloff; const float* scale; size_t dst; };

DI int rope_dim(int w, int grp) { return (w < 16) ? grp * 16 + w : 32 + grp * 16 + (w - 16); }
DI int conv_perm(int mode, int coloff, int n) {
    switch (mode) {
    case 0: return coloff + n;
    case 1: { const int t = n >> 8, q = n & 255, bj = q >> 7, wcc = (q & 127) >> 5, nn = (q & 31) >> 4, i = q & 15;
              return (bj ? 2816 : 0) + t * 128 + wcc * 32 + (i >> 2) * 8 + nn * 4 + (i & 3); }
    case 2: { const int blk = n >> 6, grp = (n >> 5) & 1, w = n & 31; return coloff + blk * 64 + rope_dim(w, grp); }
    case 3: { if (n < 768) return n; if (n >= 832) return -1; const int rr = n - 768; return 768 + rope_dim(rr & 31, rr >> 5); }
    case 4: { const int g = n >> 5, head = g / 6, gi = g - head * 6, w = n & 31; if (gi < 4) return head * 192 + gi * 32 + w; return head * 192 + 128 + rope_dim(w, gi - 4); }
    case 5: return (n >> 7) * 256 + (n & 127);
    default: return (n >> 7) * 256 + 128 + (n & 127);
    }
}

DI ConvJob get_conv_job(const Params& p, int j) {
    ConvJob c; c.scale = nullptr; c.coloff = 0; c.mode = 0; c.K = 1024; c.srcN = 1024; c.dstN = 1024;
    if (j < 8) { c.src = p.in[8] + (size_t)j * 1024 * 5632; c.srcN = 5632; c.dstN = 5632; c.mode = 1; c.dst = W_IN + (size_t)j * 5632 * 1024; }
    else if (j < 16) { c.src = p.in[9] + (size_t)(j - 8) * 2816 * 1024; c.K = 2816; c.dst = W_OUT + (size_t)(j - 8) * 1024 * 2816; }
    else switch (j) {
    case 16: c.src = p.in[10]; c.srcN = 832; c.mode = 3; c.dst = W_MLA_DOWN; break;
    case 17: c.src = p.in[13]; c.srcN = 1536; c.K = 512; c.dstN = 1536; c.mode = 4; c.scale = p.in[11]; c.dst = W_MLA_UQ; break;
    case 18: c.src = p.in[14]; c.srcN = 2048; c.K = 256; c.mode = 5; c.scale = p.in[12]; c.dst = W_MLA_UK; break;
    case 19: c.src = p.in[14]; c.srcN = 2048; c.K = 256; c.mode = 6; c.scale = p.in[12]; c.dst = W_MLA_UV; break;
    case 20: c.src = p.in[15]; c.dst = W_MLA_WO; break;
    case 21: c.src = p.in[16]; c.srcN = 1536; c.dstN = 1280; c.mode = 2; c.dst = W_SWA_QK; break;
    case 22: c.src = p.in[16]; c.srcN = 1536; c.dstN = 256; c.coloff = 1280; c.dst = W_SWA_V; break;
    case 23: c.src = p.in[18]; c.dst = W_SWA_WO; break;
    case 24: c.src = p.in[19]; c.srcN = 3072; c.dstN = 2048; c.dst = W_NA_QK; break;
    case 25: c.src = p.in[19]; c.srcN = 3072; c.coloff = 2048; c.dst = W_NA_V; break;
    case 26: c.src = p.in[21]; c.dst = W_NA_WO; break;
    case 27: c.src = p.in[22]; c.srcN = 3072; c.dstN = 2048; c.mode = 2; c.dst = W_DIFF_QK; break;
    case 28: c.src = p.in[22]; c.srcN = 3072; c.coloff = 2048; c.dst = W_DIFF_V; break;
    default: c.src = p.in[25]; c.dst = W_DIFF_WO; break;
    }
    return c;
}
constexpr int N_CONV = 30;

DI void prep_phase(const Params& p, char* lds, const int tid) {
    bf16_t* W = (bf16_t*)(p.ws + OFF_W);
    {
        constexpr int TST = 528;
        int rot = 0;
        for (int j = 0; j < N_CONV; ++j) {
            const ConvJob c = get_conv_job(p, j);
            const int nkt = c.K / 256, units = (c.dstN / 64) * nkt;
            int first = (int)blockIdx.x - rot; if (first < 0) first += gridDim.x;
            for (int u = first; u < units; u += gridDim.x) {
                const int ntile = u / nkt, kt = u % nkt;
                const int nl = tid & 63, kk = tid >> 6;
                const int sc = conv_perm(c.mode, c.coloff, ntile * 64 + nl);
                const int k0 = kt * 256 + kk * 32;
                float v[32];
#pragma unroll
                for (int i = 0; i < 32; ++i) v[i] = (sc >= 0) ? c.src[(size_t)(k0 + i) * c.srcN + sc] : 0.f;
                if (c.scale) {
#pragma unroll
                    for (int i = 0; i < 32; ++i) v[i] *= c.scale[k0 + i];
                }
#pragma unroll
                for (int i = 0; i < 16; ++i) *(unsigned*)(lds + nl * TST + (kk * 32 + 2 * i) * 2) = pack2(v[2 * i], v[2 * i + 1]);
                __syncthreads();
#pragma unroll
                for (int i = 0; i < 4; ++i) {
                    const int idx = tid + i * NTHREADS, n = idx >> 5, ch = idx & 31;
                    u32x4 w = *(const u32x4*)(lds + n * TST + ch * 16);
                    *(u32x4*)(W + c.dst + (size_t)(ntile * 64 + n) * c.K + kt * 256 + ch * 8) = w;
                }
                __syncthreads();
            }
            rot = (rot + units) % (int)gridDim.x;
        }
    }
    {
        float* sc = (float*)lds;
        float* red = (float*)(lds + 20480);
        for (int i = tid; i < 5 * 1024; i += NTHREADS) {
            const int rr = i >> 10, k = i & 1023;
            const float cv = rr < 4 ? p.in[1][rr * 1024 + k] : p.in[3][k];
            sc[i] = siluf(cv);
        }
        __syncthreads();
        float* mods = (float*)(p.ws + OFF_MODS);
        const int c4 = tid & 31, ks = tid >> 5;
        for (int u = blockIdx.x; u < 4 * 72; u += gridDim.x) {
            const int l = u / 72, n0 = (u % 72) * 128;
            const float* wp = p.in[4] + (size_t)l * 1024 * 9216 + n0 + c4 * 4;
            f32x4 a0 = {0, 0, 0, 0}, a1 = a0, a2 = a0, a3 = a0, a4 = a0;
#pragma unroll 8
            for (int kk = 0; kk < 64; ++kk) {
                const int k = ks * 64 + kk;
                const f32x4 w = *(const f32x4*)(wp + (size_t)k * 9216);
                a0 += w * sc[k]; a1 += w * sc[1024 + k]; a2 += w * sc[2048 + k]; a3 += w * sc[3072 + k]; a4 += w * sc[4096 + k];
            }
            *(f32x4*)(red + (ks * 5 + 0) * 128 + c4 * 4) = a0; *(f32x4*)(red + (ks * 5 + 1) * 128 + c4 * 4) = a1;
            *(f32x4*)(red + (ks * 5 + 2) * 128 + c4 * 4) = a2; *(f32x4*)(red + (ks * 5 + 3) * 128 + c4 * 4) = a3;
            *(f32x4*)(red + (ks * 5 + 4) * 128 + c4 * 4) = a4;
            __syncthreads();
            for (int i = tid; i < 5 * 128; i += NTHREADS) {
                const int rr = i >> 7, cc = i & 127;
                float s = p.in[5][l * 9216 + n0 + cc];
#pragma unroll
                for (int q = 0; q < 16; ++q) s += red[(q * 5 + rr) * 128 + cc];
                mods[((size_t)l * 5 + rr) * 9216 + n0 + cc] = s;
            }
            __syncthreads();
        }
    }
    {
        float* cosT = (float*)(p.ws + OFF_COS); float* sinT = (float*)(p.ws + OFF_SIN);
        for (int i = blockIdx.x * NTHREADS + tid; i < 4096 * 32; i += gridDim.x * NTHREADS) {
            const int pos = i >> 5, d = i & 31, f = d & 15;
            const float inv = expf(-9.210340371976184f * (float)f / 16.0f);
            const float base = (d < 16) ? (float)(pos >> 6) : (float)(pos & 63);
            const float ang = base * inv;
            float rev = ang * 0.15915494309189535f; rev = rev - floorf(rev);
            cosT[i] = __builtin_amdgcn_cosf(rev); sinT[i] = __builtin_amdgcn_sinf(rev);
        }
    }
    {
        f32x4* X4 = (f32x4*)(p.ws + OFF_X);
        const f32x4* x4 = (const f32x4*)p.in[0]; const f32x4* c4p = (const f32x4*)p.in[2];
        const size_t nlat4 = (size_t)NLAT * 256, nall4 = (size_t)MT * 256;
        for (size_t i = (size_t)blockIdx.x * NTHREADS + tid; i < nall4; i += (size_t)gridDim.x * NTHREADS)
            X4[i] = i < nlat4 ? x4[i] : c4p[i - nlat4];
    }
}

constexpr int N_PHASES = 1 + 4 * 11 + 1;
__host__ __device__ inline bool phase_is_noop(int ph) {
    if (ph == 0 || ph == N_PHASES - 1) return false;
    const int layer = (ph - 1) / 11, slot = (ph - 1) % 11;
    return slot == 5 && layer != 0;
}

DI GemmJob get_job(const Params& p, int layer, int slot, int jidx, int& nj, const bool dry) {
    char* ws = p.ws;
    bf16_t* W = (bf16_t*)(ws + OFF_W);
    float* X = (float*)(ws + OFF_X);
    bf16_t* H = (bf16_t*)(ws + OFF_H);
    bf16_t* R = (bf16_t*)(ws + OFF_R);
    bf16_t* RQ = (bf16_t*)(ws + OFF_R + R_Q); bf16_t* RK = (bf16_t*)(ws + OFF_R + R_K);
    bf16_t* RVT = (bf16_t*)(ws + OFF_R + R_VT); bf16_t* RD = (bf16_t*)(ws + OFF_R + R_DRAW);
    const float* mods_l = (const float*)(ws + OFF_MODS) + (size_t)layer * 5 * 9216;
    float* stats = (float*)(ws + OFF_STATS);
    const float* cosT = (const float*)(ws + OFF_COS); const float* sinT = (const float*)(ws + OFF_SIN);
    const bool last = layer == 3;
    GemmJob j; j.o0 = j.o1 = nullptr; j.o2 = nullptr; j.f0 = j.f1 = nullptr; j.i0 = 0; j.s0 = 0.f; j.ksplit = 1; j.row0 = 0;
    if (slot == 1 || slot == 9) {
        const int f = slot == 1 ? 0 : 1;
        j.A = H; j.lda = 1024; j.B = W + W_IN + (size_t)(layer * 2 + f) * 5632 * 1024; j.ldb = 1024;
        j.M = (last && f == 1) ? NLAT : MT; j.N = 5632; j.K = 1024; j.epi = EPI_SWIGLU; j.o0 = R;
        nj = 1; return j;
    }
    if (slot == 2 || slot == 10) {
        const int f = slot == 2 ? 0 : 1;
        j.A = R; j.lda = DFF; j.B = W + W_OUT + (size_t)(layer * 2 + f) * 1024 * 2816; j.ldb = DFF;
        j.M = NLAT; j.N = 1024; j.K = DFF; j.epi = EPI_RESID; j.o0 = X;
        j.f0 = mods_l + (f == 0 ? 2 : 8) * 1024; j.s0 = 0.5f;
        nj = (last && f == 1) ? 1 : 2;
        if (dry) { nj = 1; j.s0 = 0.f; }
        if (jidx == 1) { j.A = R + (size_t)NLAT * DFF; j.M = MT - NLAT; j.row0 = NLAT; j.ksplit = 11; j.epi = EPI_RESID_ATOMIC; j.o2 = (float*)(ws + OFF_R + R_VT); }
        return j;
    }
    if (slot == 7) {
        const size_t wo = layer == 0 ? W_MLA_WO : layer == 1 ? W_SWA_WO : layer == 2 ? W_NA_WO : W_DIFF_WO;
        j.A = H; j.lda = 1024; j.B = W + wo; j.ldb = 1024; j.M = NLAT; j.N = 1024; j.K = 1024;
        j.epi = EPI_RESID; j.o0 = X; j.f0 = mods_l + 5 * 1024; j.s0 = 1.0f;
        nj = last ? 1 : 2;
        if (dry) { nj = 1; j.s0 = 0.f; }
        if (jidx == 1) { j.A = H + (size_t)NLAT * 1024; j.M = MT - NLAT; j.row0 = NLAT; j.ksplit = 4; j.epi = EPI_RESID_ATOMIC; j.o2 = (float*)(ws + OFF_R + R_DRAW); }
        return j;
    }
    if (slot == 4) {
        if (layer == 0) {
            j.A = H; j.lda = 1024; j.B = W + W_MLA_DOWN; j.ldb = 1024; j.M = MT; j.N = 1024; j.K = 1024;
            j.epi = EPI_MLA_DOWN; j.o0 = RD; j.o1 = RK; j.o2 = stats; j.f0 = cosT; j.f1 = sinT;
            nj = 1; return j;
        }
        j.A = H; j.lda = 1024; j.ldb = 1024; j.M = MT; j.K = 1024; j.o0 = RQ; j.o1 = RK;
        if (layer == 1) { j.B = W + W_SWA_QK; j.N = 1280; j.epi = EPI_ROPE; j.i0 = 16; j.f0 = cosT; j.f1 = sinT; }
        else if (layer == 2) { j.B = W + W_NA_QK; j.N = 2048; j.epi = EPI_PLAIN2; }
        else { j.B = W + W_DIFF_QK; j.N = 2048; j.epi = EPI_ROPE; j.i0 = 16; j.f0 = cosT; j.f1 = sinT; }
        nj = 2;
        if (jidx == 0) return j;
        GemmJob v; v.o1 = nullptr; v.o2 = nullptr; v.f0 = v.f1 = nullptr; v.i0 = 0; v.s0 = 0.f; v.ksplit = 1; v.row0 = 0;
        v.A = W + (layer == 1 ? W_SWA_V : layer == 2 ? W_NA_V : W_DIFF_V); v.lda = 1024; v.B = H; v.ldb = 1024;
        v.M = layer == 1 ? 256 : 1024; v.N = MT; v.K = 1024; v.epi = EPI_VT; v.o0 = RVT;
        return v;
    }
    j.A = RD; j.lda = 1024; j.B = W + W_MLA_UQ; j.ldb = 512; j.M = MT; j.N = 1536; j.K = 512;
    j.epi = EPI_MLA_Q; j.o0 = RQ; j.o1 = (void*)cosT; j.f0 = stats; j.f1 = sinT;
    nj = 3;
    if (jidx == 0) return j;
    GemmJob k = j; k.A = RD + 512; k.B = W + W_MLA_UK; k.ldb = 256; k.N = 1024; k.K = 256; k.epi = EPI_MLA_K; k.o0 = RK; k.o1 = nullptr; k.f1 = nullptr;
    if (jidx == 1) return k;
    GemmJob v = k; v.A = W + W_MLA_UV; v.lda = 256; v.B = RD + 512; v.ldb = 1024; v.M = 1024; v.N = MT; v.epi = EPI_VT; v.o0 = RVT; v.i0 = 1;
    return v;
}

DI void run_phase(const Params& p, int ph, char* lds, const int wave_s, const bool dry = false) {
    char* ws = p.ws;
    float* X = (float*)(ws + OFF_X);
    bf16_t* H = (bf16_t*)(ws + OFF_H);
#ifndef NO_PREP
    if (ph == 0) { prep_phase(p, lds, fresh_tid(wave_s)); return; }
#endif
    if (ph == N_PHASES - 1) { final_phase(X, p.in[7], p.out, fresh_tid(wave_s)); return; }
    const int layer = (ph - 1) / 11, slot = (ph - 1) % 11;
    const float* mods_l = (const float*)(ws + OFF_MODS) + (size_t)layer * 5 * 9216;
    const bool last = layer == 3;
    if (slot == 0 || slot == 3 || slot == 8) {
        const int sub = slot == 0 ? 0 : slot == 3 ? 1 : 2;
        const float* part = (sub == 2) ? (const float*)(ws + OFF_R + R_DRAW) : (const float*)(ws + OFF_R + R_VT);
        const int npart = (sub == 2) ? 4 : ((sub == 0 && layer == 0) ? 0 : 11);
        norm_phase(X, p.in[6] + (size_t)(layer * 3 + sub) * 1024, mods_l, sub * 3, sub * 3 + 1, H, (last && sub == 2) ? NLAT : MT, fresh_tid(wave_s), part, (last && sub == 2) ? 0 : npart);
        return;
    }
#ifndef NO_ATTN
    if (slot == 6) {
        const int tid = fresh_tid(wave_s);
        AttnArgs a;
        a.q = (const bf16_t*)(ws + OFF_R + R_Q); a.k = (const bf16_t*)(ws + OFF_R + R_K); a.vt = (const bf16_t*)(ws + OFF_R + R_VT);
        a.ao = H; a.sink = nullptr; a.rpb = nullptr; a.lamp = nullptr; a.ng = nullptr; a.lam_init = 0.f; a.ctx_units = last ? 0 : 1;
        if (layer == 0) {
            a.q_ts = 2048; a.q_hs = 256; a.q_rot = 128; a.q_plain = 192; a.k_ts = 1536; a.k_hs = 192; a.NH = 8; a.scale = 0.07216878364870322f;
            attn_phase<192, 128, 0, false>(a, lds, tid);
        } else if (layer == 1) {
            a.q_ts = 2048; a.q_hs = 128; a.q_rot = 0; a.q_plain = 64; a.k_ts = 256; a.k_hs = 64; a.NH = 16; a.scale = 0.125f; a.sink = p.in[17];
            attn_phase<64, 64, 1, false>(a, lds, tid);
        } else if (layer == 2) {
            a.q_ts = 1024; a.q_hs = 64; a.q_rot = 0; a.q_plain = 0; a.k_ts = 1024; a.k_hs = 64; a.NH = 16; a.scale = 0.125f; a.rpb = p.in[20];
            attn_phase<64, 64, 2, false>(a, lds, tid);
        } else {
            a.q_ts = 2048; a.q_hs = 128; a.q_rot = 0; a.q_plain = 64; a.k_ts = 1024; a.k_hs = 128; a.NH = 8; a.scale = 0.125f;
            a.lamp = p.in[23]; a.ng = p.in[24]; a.lam_init = 0.5560582f;
            attn_phase<64, 128, 0, true>(a, lds, tid);
        }
        return;
    }
#endif
#ifndef NO_GEMM
    int nj = 1, rot = 0;
#pragma unroll 1
    for (int j = 0; j < nj; ++j) {
        const GemmJob job = get_job(p, layer, slot, j, nj, dry);
        gemm_run(job, lds, wave_s, rot);
        rot = (rot + (job.M / BM) * (job.N / BM) * job.ksplit) % (int)gridDim.x;
    }
#endif
}

__global__ void __launch_bounds__(NTHREADS) mega_kernel(Params p, int ph_lo, int ph_hi) {
    extern __shared__ __attribute__((aligned(16))) char lds[];
    cg::grid_group grid = cg::this_grid();
    const int wave_s = __builtin_amdgcn_readfirstlane(threadIdx.x >> 6);
    if (ph_lo > ph_hi) grid.sync();
    XcdBarrier xb; xb.bar = (unsigned*)(p.ws + OFF_BAR); xb.x = xb_xcc_id(); xb.st = (volatile LAS unsigned*)&lds[131072];
    if (ph_hi - ph_lo > 1) {
        const bool t0 = fresh_tid(wave_s) == 0;
        if (t0) { xb.st[0] = 0u; xb.st[1] = 0u; }
        __syncthreads();
        if (t0) (void)xb_add(&xb.bar[XB_XCNT(xb.x)], 1u);
    }
#pragma unroll 1
    for (int ph = ph_lo; ph < ph_hi; ++ph) {
        if (phase_is_noop(ph)) continue;
        run_phase(p, ph, lds, wave_s);
        if (PROBE_DUP) {
            const int slot_ = (ph >= 1 && ph < N_PHASES - 1) ? (ph - 1) % 11 : -1;
            bool dup = false;
            if (PROBE_DUP == 1) dup = ph == 0;
            if (PROBE_DUP == 3) dup = slot_ == 6;
            if (PROBE_DUP >= 30 && PROBE_DUP < 34) dup = slot_ == 6 && (ph - 1) / 11 == PROBE_DUP - 30;
            if (PROBE_DUP == 4) dup = slot_ == 0 || slot_ == 3 || slot_ == 8;
            if (PROBE_DUP == 5) dup = slot_ == 1 || slot_ == 9;
            if (PROBE_DUP == 6) dup = slot_ == 4 || slot_ == 5;
            if (PROBE_DUP == 7) dup = slot_ == 2 || slot_ == 10;
            if (PROBE_DUP == 8) dup = slot_ == 7;
            if (PROBE_DUP == 2) xcd_barrier(xb, fresh_tid(wave_s) == 0);
            if (dup) { xcd_barrier(xb, fresh_tid(wave_s) == 0); run_phase(p, ph, lds, wave_s, PROBE_DUP >= 7); }
        }
        if (ph + 1 < ph_hi) xcd_barrier(xb, fresh_tid(wave_s) == 0);
    }
}

extern "C" void kernel_launch(void* const* d_in, const int* in_sizes, int n_in, void* d_out, int out_size, void* d_ws, size_t ws_size,
                              hipStream_t stream) {
    static int grid_blocks = 0;
    if (!grid_blocks) {
        (void)hipFuncSetAttribute((const void*)mega_kernel, hipFuncAttributeMaxDynamicSharedMemorySize, LDS_BYTES);
        int dev = 0, cus = 0, per_cu = 0;
        (void)hipGetDevice(&dev);
        (void)hipDeviceGetAttribute(&cus, hipDeviceAttributeMultiprocessorCount, dev);
        (void)hipOccupancyMaxActiveBlocksPerMultiprocessor(&per_cu, mega_kernel, NTHREADS, LDS_BYTES);
        if (per_cu < 1) per_cu = 1;
        if (per_cu > 1) per_cu = 1;
        grid_blocks = cus * per_cu;
        grid_blocks -= grid_blocks % 8;
        if (ws_size < WS_NEED) fprintf(stderr, "workspace too small: %zu < %zu\n", ws_size, (size_t)WS_NEED);
    }
    Params p{};
    for (int i = 0; i < 26; ++i) p.in[i] = (const float*)d_in[i];
    p.out = (float*)d_out; p.ws = (char*)d_ws;
#if MK_SINGLE
    (void)hipMemsetAsync((char*)d_ws + OFF_BAR, 0, 16384, stream);
    int lo = 0, hi = N_PHASES;
    void* args[] = {&p, &lo, &hi};
    hipError_t e = hipLaunchCooperativeKernel((const void*)mega_kernel, dim3(grid_blocks), dim3(NTHREADS), args, LDS_BYTES, stream);
    if (e != hipSuccess) fprintf(stderr, "cooperative launch failed: %s (grid %d)\n", hipGetErrorString(e), grid_blocks);
#else
    for (int ph = 0; ph < N_PHASES; ++ph) {
        if (phase_is_noop(ph)) continue;
        mega_kernel<<<dim3(grid_blocks), dim3(NTHREADS), LDS_BYTES, stream>>>(p, ph, ph + 1);
    }
#endif
}
```

```cpp
#include <hip/hip_runtime.h>
#include <hip/hip_cooperative_groups.h>
#include <cstdio>
#include <cstdint>
namespace cg = cooperative_groups;

#ifndef MK_SINGLE
#define MK_SINGLE 1
#endif
#define PROBE_DUP 0

typedef unsigned short bf16_t;
typedef short bf16x8 __attribute__((ext_vector_type(8)));
typedef short s16x4 __attribute__((ext_vector_type(4)));
typedef float f32x4 __attribute__((ext_vector_type(4)));
typedef float f32x2 __attribute__((ext_vector_type(2)));
typedef float f32x16 __attribute__((ext_vector_type(16)));
typedef unsigned u32x4 __attribute__((ext_vector_type(4)));
typedef unsigned u32x2 __attribute__((ext_vector_type(2)));
typedef __bf16 bf2_t __attribute__((ext_vector_type(2)));
#define DI __device__ __forceinline__

constexpr int MT = 17408;
constexpr int NLAT = 16384;
constexpr int DM = 1024;
constexpr int DFF = 2816;
constexpr int NTHREADS = 512;
constexpr int LDS_BYTES = 131072 + 16;
constexpr float EPSV = 1e-6f;
constexpr float LOG2E = 1.4426950408889634f;
constexpr float RESCALE_THR = 8.0f;

constexpr size_t al256(size_t x) { return (x + 255) & ~(size_t)255; }
constexpr size_t OFF_BAR = 0;
constexpr size_t OFF_MODS = 16384;
constexpr size_t OFF_COS = al256(OFF_MODS + (size_t)4 * 5 * 9216 * 4);
constexpr size_t OFF_SIN = al256(OFF_COS + (size_t)4096 * 32 * 4);
constexpr size_t OFF_STATS = al256(OFF_SIN + (size_t)4096 * 32 * 4);
constexpr size_t OFF_X = al256(OFF_STATS + (size_t)MT * 16 * 4);
constexpr size_t OFF_H = al256(OFF_X + (size_t)MT * 1024 * 4);
constexpr size_t OFF_W = al256(OFF_H + (size_t)MT * 1024 * 2);
constexpr size_t W_IN = 0;
constexpr size_t W_OUT = W_IN + (size_t)8 * 5632 * 1024;
constexpr size_t W_MLA_DOWN = W_OUT + (size_t)8 * 1024 * 2816;
constexpr size_t W_MLA_UQ = W_MLA_DOWN + (size_t)1024 * 1024;
constexpr size_t W_MLA_UK = W_MLA_UQ + (size_t)1536 * 512;
constexpr size_t W_MLA_UV = W_MLA_UK + (size_t)1024 * 256;
constexpr size_t W_MLA_WO = W_MLA_UV + (size_t)1024 * 256;
constexpr size_t W_SWA_QK = W_MLA_WO + (size_t)1024 * 1024;
constexpr size_t W_SWA_V = W_SWA_QK + (size_t)1280 * 1024;
constexpr size_t W_SWA_WO = W_SWA_V + (size_t)256 * 1024;
constexpr size_t W_NA_QK = W_SWA_WO + (size_t)1024 * 1024;
constexpr size_t W_NA_V = W_NA_QK + (size_t)2048 * 1024;
constexpr size_t W_NA_WO = W_NA_V + (size_t)1024 * 1024;
constexpr size_t W_DIFF_QK = W_NA_WO + (size_t)1024 * 1024;
constexpr size_t W_DIFF_V = W_DIFF_QK + (size_t)2048 * 1024;
constexpr size_t W_DIFF_WO = W_DIFF_V + (size_t)1024 * 1024;
constexpr size_t W_TOTAL = W_DIFF_WO + (size_t)1024 * 1024;
constexpr size_t OFF_R = al256(OFF_W + W_TOTAL * 2);
constexpr size_t R_Q = 0;
constexpr size_t R_K = al256(R_Q + (size_t)MT * 2048 * 2);
constexpr size_t R_VT = al256(R_K + (size_t)MT * 1536 * 2);
constexpr size_t R_DRAW = al256(R_VT + (size_t)1024 * MT * 2);
constexpr size_t R_END = al256(R_DRAW + (size_t)MT * 1024 * 2);
constexpr size_t WS_NEED = OFF_R + R_END;

struct Params {
    const float* in[26];
    float* out;
    char* ws;
};

DI unsigned pack2(float lo, float hi) {
    f32x2 v = {lo, hi};
    bf2_t b = __builtin_convertvector(v, bf2_t);
    return __builtin_bit_cast(unsigned, b);
}
DI u32x2 pack4(f32x4 v) { u32x2 r; r.x = pack2(v[0], v[1]); r.y = pack2(v[2], v[3]); return r; }
DI float fexp2(float x) { return __builtin_amdgcn_exp2f(x); }
DI float siluf(float g) { return g * __builtin_amdgcn_rcpf(1.0f + __builtin_amdgcn_exp2f(-g * LOG2E)); }
DI int mod_row(int row) { return row < NLAT ? (row >> 12) : 4; }
template <int M> DI float swz_xor(float x) { return __int_as_float(__builtin_amdgcn_ds_swizzle(__float_as_int(x), (M << 10) | 0x1f)); }
DI float max_x32(float x) {
    auto r = __builtin_amdgcn_permlane32_swap(__float_as_uint(x), __float_as_uint(x), false, false);
    return fmaxf(__uint_as_float(r[0]), __uint_as_float(r[1]));
}
DI float bperm(float x, int addr) { return __int_as_float(__builtin_amdgcn_ds_bpermute(addr, __float_as_int(x))); }
DI float wave_sum(float x, int lane) {
    x += bperm(x, (lane ^ 32) << 2);
    x += swz_xor<16>(x); x += swz_xor<8>(x); x += swz_xor<4>(x); x += swz_xor<2>(x); x += swz_xor<1>(x);
    return x;
}
DI int fresh_tid(int wave_s) {
    int lane;
    asm volatile("v_mbcnt_lo_u32_b32 %0, -1, 0\n\tv_mbcnt_hi_u32_b32 %0, -1, %0" : "=v"(lane));
    return wave_s * 64 + lane;
}


#define XB_TMO      128
#define XB_XCNT(j)  (256  + 64 * (j))
#define XB_XSUB(j)  (1280 + 64 * (j))
#define XB_XGEN(j)  (2304 + 64 * (j))
#define XB_TOP      3328
#define XB_TOPGEN   3392
#define XCD_BAR_WORDS 3456
#define XB_SPIN_CAP (1u << 18)
#define LAS __attribute__((address_space(3)))
DI unsigned xb_ld(unsigned* p) { return __hip_atomic_load(p, __ATOMIC_RELAXED, __HIP_MEMORY_SCOPE_AGENT); }
DI unsigned xb_add(unsigned* p, unsigned v) { return __hip_atomic_fetch_add(p, v, __ATOMIC_RELAXED, __HIP_MEMORY_SCOPE_AGENT); }
DI unsigned xb_xcc_id() { return (unsigned)__builtin_amdgcn_s_getreg((3 << 11) | 20) & 0xFu; }
#define XB_SPIN(cond, bar) do { unsigned _sp = 0; while (cond) { __builtin_amdgcn_s_sleep(1); \
    if ((++_sp & 255u) == 0u) { if (xb_ld(&(bar)[XB_TMO])) break; if (_sp > XB_SPIN_CAP) { atomicAdd(&(bar)[XB_TMO], 1u); break; } } } } while (0)
struct XcdBarrier { unsigned* bar; unsigned x; volatile LAS unsigned* st; };
DI void xcd_barrier_complete(unsigned* bar, unsigned x, unsigned& nloc, unsigned& nx) {
    const unsigned G = gridDim.x * gridDim.y * gridDim.z;
    unsigned sum, cnt, mine, sp = 0u;
    for (;;) {
        sum = 0u; cnt = 0u; mine = 0u;
#pragma unroll
        for (unsigned j = 0; j < 16; ++j) { const unsigned c = xb_ld(&bar[XB_XCNT(j)]); sum += c; cnt += (c > 0u) ? 1u : 0u; mine = (j == x) ? c : mine; }
        if (sum == G) break;
        __builtin_amdgcn_s_sleep(1);
        if ((++sp & 255u) == 0u) { if (xb_ld(&bar[XB_TMO])) break; if (sp > XB_SPIN_CAP) { atomicAdd(&bar[XB_TMO], 1u); break; } }
    }
    nloc = mine > 0u ? mine : 1u; nx = cnt > 0u ? cnt : 1u;
}
DI void xcd_barrier(const XcdBarrier& b, const bool leader_thread) {
    asm volatile("s_waitcnt vmcnt(0)" ::: "memory");
    __syncthreads();
    if (leader_thread) {
        unsigned* bar = b.bar;
        __builtin_amdgcn_s_waitcnt(0);
        unsigned nloc = b.st[0], nx = b.st[1];
        if (nloc == 0u) { xcd_barrier_complete(bar, b.x, nloc, nx); b.st[0] = nloc; b.st[1] = nx; }
        const unsigned old = xb_add(&bar[XB_XSUB(b.x)], 1u);
        const unsigned gen = old / nloc;
        if (old + 1u == (gen + 1u) * nloc) {
            __builtin_amdgcn_fence(__ATOMIC_RELEASE, "agent");
            asm volatile("s_waitcnt vmcnt(0)" ::: "memory");
            const unsigned og = xb_add(&bar[XB_TOP], 1u);
            const unsigned tg = og / nx;
            if (og + 1u == (tg + 1u) * nx) xb_add(&bar[XB_TOPGEN], 1u);
            else XB_SPIN(xb_ld(&bar[XB_TOPGEN]) == tg, bar);
            __builtin_amdgcn_fence(__ATOMIC_ACQUIRE, "agent");
            xb_add(&bar[XB_XGEN(b.x)], 1u);
            asm volatile("s_waitcnt vmcnt(0)" ::: "memory");
        } else {
            XB_SPIN(xb_ld(&bar[XB_XGEN(b.x)]) == gen, bar);
            __builtin_amdgcn_fence(__ATOMIC_ACQUIRE, "agent");
            asm volatile("s_waitcnt vmcnt(0)" ::: "memory");
        }
    }
    __syncthreads();
}

constexpr int BM = 256, BK = 64, HALF = 128, HT = HALF * BK;
DI int lds_byte(int r, int c) {
    int st = (r >> 4) * 2 + (c >> 5), rr = r & 15, cc = c & 31, ob = rr * 64 + cc * 2;
    return st * 1024 + (ob ^ (((ob >> 9) & 1) << 5));
}
DI void stage_rc(int b, int& R, int& C) {
    int st = b / 1024, sb = b % 1024, swz = sb ^ (((sb >> 9) & 1) << 5);
    R = (st >> 1) * 16 + swz / 64; C = (st & 1) * 32 + (swz % 64) / 2;
}

enum { EPI_RESID = 0, EPI_RESID_ATOMIC, EPI_SWIGLU, EPI_PLAIN2, EPI_ROPE, EPI_MLA_DOWN, EPI_MLA_Q, EPI_MLA_K, EPI_VT };

struct GemmJob {
    const bf16_t* A; const bf16_t* B; int lda, ldb, M, N, K, epi;
    void* o0; void* o1; float* o2; const float* f0; const float* f1; int i0; float s0; int ksplit, row0;
};

DI void gemm_epilogue(const GemmJob& J, f32x4 (&acc)[2][2][4][2], int brow, int bcol, int wr, int wc, int fr, int fq, int ks) {
    const int epi = J.epi;
    if (epi == EPI_RESID) {
        const float* gp = J.f0 + (size_t)mod_row(brow) * 9216;
        const float cf = J.s0;
        f32x4 gv[2][2];
#pragma unroll
        for (int bj = 0; bj < 2; ++bj)
#pragma unroll
            for (int n = 0; n < 2; ++n) gv[bj][n] = *(const f32x4*)(gp + bcol + bj * HALF + wc * 32 + n * 16 + fq * 4) * cf;
#pragma unroll
        for (int ai = 0; ai < 2; ++ai) {
            f32x4 xv[4][2][2];
#pragma unroll
            for (int m = 0; m < 4; ++m) {
                const float* xp = (const float*)J.o0 + (size_t)(brow + ai * HALF + wr * 64 + m * 16 + fr) * DM + bcol + wc * 32 + fq * 4;
#pragma unroll
                for (int bj = 0; bj < 2; ++bj)
#pragma unroll
                    for (int n = 0; n < 2; ++n) xv[m][bj][n] = *(const f32x4*)(xp + bj * HALF + n * 16);
            }
            __builtin_amdgcn_sched_barrier(0);
#pragma unroll
            for (int m = 0; m < 4; ++m) {
                float* xp = (float*)J.o0 + (size_t)(brow + ai * HALF + wr * 64 + m * 16 + fr) * DM + bcol + wc * 32 + fq * 4;
#pragma unroll
                for (int bj = 0; bj < 2; ++bj)
#pragma unroll
                    for (int n = 0; n < 2; ++n) *(f32x4*)(xp + bj * HALF + n * 16) = xv[m][bj][n] + gv[bj][n] * acc[ai][bj][m][n];
            }
            __builtin_amdgcn_sched_barrier(0);
        }
        return;
    }
#pragma unroll
    for (int ai = 0; ai < 2; ++ai)
#pragma unroll
        for (int m = 0; m < 4; ++m) {
            const int row = brow + ai * HALF + wr * 64 + m * 16 + fr;
            if (epi == EPI_RESID) {
                const float* gp = J.f0 + (size_t)mod_row(row) * 9216;
                float* xp = (float*)J.o0 + (size_t)row * DM;
                const float cf = J.s0;
#pragma unroll
                for (int bj = 0; bj < 2; ++bj)
#pragma unroll
                    for (int n = 0; n < 2; ++n) {
                        const int col = bcol + bj * HALF + wc * 32 + n * 16 + fq * 4;
                        f32x4 g = *(const f32x4*)(gp + col);
                        f32x4 x = *(const f32x4*)(xp + col);
                        x += (g * cf) * acc[ai][bj][m][n];
                        *(f32x4*)(xp + col) = x;
                    }
            } else if (epi == EPI_RESID_ATOMIC) {
                const float* gp = J.f0 + (size_t)mod_row(row) * 9216;
                float* pp = J.o2 + ((size_t)ks * (MT - NLAT) + (row - NLAT)) * DM;
                const float cf = J.s0;
#pragma unroll
                for (int bj = 0; bj < 2; ++bj)
#pragma unroll
                    for (int n = 0; n < 2; ++n) {
                        const int col = bcol + bj * HALF + wc * 32 + n * 16 + fq * 4;
                        f32x4 g = *(const f32x4*)(gp + col);
                        *(f32x4*)(pp + col) = (g * cf) * acc[ai][bj][m][n];
                    }
            } else if (epi == EPI_SWIGLU) {
                bf16_t* op = (bf16_t*)J.o0 + (size_t)row * DFF + (bcol >> 1) + wc * 32 + fq * 8;
                f32x4 o0, o1;
#pragma unroll
                for (int j = 0; j < 4; ++j) { o0[j] = siluf(acc[ai][0][m][0][j]) * acc[ai][1][m][0][j]; o1[j] = siluf(acc[ai][0][m][1][j]) * acc[ai][1][m][1][j]; }
                u32x4 w; { const u32x2 a = pack4(o0), b = pack4(o1); w.x = a.x; w.y = a.y; w.z = b.x; w.w = b.y; }
                *(u32x4*)op = w;
            } else if (epi == EPI_PLAIN2) {
                bf16_t* q = (bf16_t*)J.o0 + (size_t)row * 1024;
                bf16_t* k = (bf16_t*)J.o1 + (size_t)row * 1024;
#pragma unroll
                for (int bj = 0; bj < 2; ++bj)
#pragma unroll
                    for (int n = 0; n < 2; ++n) {
                        const int col = bcol + bj * HALF + wc * 32 + n * 16 + fq * 4;
                        bf16_t* d = col < 1024 ? q + col : k + (col - 1024);
                        *(u32x2*)d = pack4(acc[ai][bj][m][n]);
                    }
            } else if (epi == EPI_ROPE) {
                const int NQH = J.i0, NKH = (J.N >> 6) - NQH;
                const bool latent = row < NLAT;
                const int pos = row & 4095;
#pragma unroll
                for (int bj = 0; bj < 2; ++bj) {
                    const int gcol = bcol + bj * HALF + wc * 32;
                    const int head64 = gcol >> 6, di = ((gcol >> 5) & 1) * 16 + fq * 4;
                    f32x4 v0 = acc[ai][bj][m][0], v1 = acc[ai][bj][m][1], r1 = v0, r2 = v1;
                    if (latent) {
                        f32x4 c4 = *(const f32x4*)(J.f0 + pos * 32 + di), s4 = *(const f32x4*)(J.f1 + pos * 32 + di);
                        r1 = v0 * c4 - v1 * s4; r2 = v0 * s4 + v1 * c4;
                    }
                    if (head64 < NQH) {
                        bf16_t* q = (bf16_t*)J.o0 + (size_t)row * (NQH * 128) + head64 * 128;
                        *(u32x2*)(q + 64 + di) = pack4(v0); *(u32x2*)(q + 96 + di) = pack4(v1);
                        *(u32x2*)(q + di) = pack4(r1); *(u32x2*)(q + 32 + di) = pack4(r2);
                    } else {
                        bf16_t* k = (bf16_t*)J.o1 + (size_t)row * (NKH * 64) + (head64 - NQH) * 64;
                        *(u32x2*)(k + di) = pack4(r1); *(u32x2*)(k + 32 + di) = pack4(r2);
                    }
                }
            } else if (epi == EPI_MLA_DOWN) {
                const int pn = bcol >> 8;
                if (pn < 3) {
                    bf16_t* d = (bf16_t*)J.o0 + (size_t)row * 1024;
                    float ss = 0.f;
#pragma unroll
                    for (int bj = 0; bj < 2; ++bj)
#pragma unroll
                        for (int n = 0; n < 2; ++n) {
                            const int col = bcol + bj * HALF + wc * 32 + n * 16 + fq * 4;
                            f32x4 v = acc[ai][bj][m][n];
                            ss += v[0] * v[0] + v[1] * v[1] + v[2] * v[2] + v[3] * v[3];
                            *(u32x2*)(d + col) = pack4(v);
                        }
                    ss += swz_xor<16>(ss); ss += bperm(ss, ((fq * 16 + fr) ^ 32) << 2);
                    if (fq == 0) J.o2[(size_t)row * 16 + pn * 4 + wc] = ss;
                } else if (wc < 2) {
                    const bool latent = row < NLAT;
                    const int pos = row & 4095, di = wc * 16 + fq * 4;
                    f32x4 v0 = acc[ai][0][m][0], v1 = acc[ai][0][m][1], r1 = v0, r2 = v1;
                    if (latent) {
                        f32x4 c4 = *(const f32x4*)(J.f0 + pos * 32 + di), s4 = *(const f32x4*)(J.f1 + pos * 32 + di);
                        r1 = v0 * c4 - v1 * s4; r2 = v0 * s4 + v1 * c4;
                    }
                    u32x2 p1 = pack4(r1), p2 = pack4(r2);
                    bf16_t* k = (bf16_t*)J.o1 + (size_t)row * 1536 + 128 + di;
#pragma unroll
                    for (int hh = 0; hh < 8; ++hh) { *(u32x2*)(k + hh * 192) = p1; *(u32x2*)(k + hh * 192 + 32) = p2; }
                }
            } else if (epi == EPI_MLA_Q) {
                const float* sp = J.f0 + (size_t)row * 16;
                f32x4 a = *(const f32x4*)sp, b = *(const f32x4*)(sp + 4);
                const float rstd = rsqrtf((a[0] + a[1] + a[2] + a[3] + b[0] + b[1] + b[2] + b[3]) * (1.0f / 512.0f) + EPSV);
                const bool latent = row < NLAT;
                const int pos = row & 4095;
                const float* cosT = (const float*)J.o1; const float* sinT = J.f1;
#pragma unroll
                for (int bj = 0; bj < 2; ++bj) {
                    const int g = (bcol + bj * HALF + wc * 32) >> 5;
                    const int head = g / 6, gi = g - head * 6;
                    bf16_t* q = (bf16_t*)J.o0 + (size_t)row * 2048 + head * 256;
                    f32x4 v0 = acc[ai][bj][m][0] * rstd, v1 = acc[ai][bj][m][1] * rstd;
                    if (gi < 4) {
                        *(u32x2*)(q + gi * 32 + fq * 4) = pack4(v0); *(u32x2*)(q + gi * 32 + 16 + fq * 4) = pack4(v1);
                    } else {
                        const int di = (gi - 4) * 16 + fq * 4;
                        *(u32x2*)(q + 192 + di) = pack4(v0); *(u32x2*)(q + 224 + di) = pack4(v1);
                        if (latent) {
                            f32x4 c4 = *(const f32x4*)(cosT + pos * 32 + di), s4 = *(const f32x4*)(sinT + pos * 32 + di);
                            *(u32x2*)(q + 128 + di) = pack4(v0 * c4 - v1 * s4); *(u32x2*)(q + 160 + di) = pack4(v0 * s4 + v1 * c4);
                        }
                    }
                }
            } else if (epi == EPI_MLA_K) {
                f32x4 a = *(const f32x4*)(J.f0 + (size_t)row * 16 + 8);
                const float rstd = rsqrtf((a[0] + a[1] + a[2] + a[3]) * (1.0f / 256.0f) + EPSV);
                bf16_t* k = (bf16_t*)J.o0 + (size_t)row * 1536;
#pragma unroll
                for (int bj = 0; bj < 2; ++bj)
#pragma unroll
                    for (int n = 0; n < 2; ++n) {
                        const int col = bcol + bj * HALF + wc * 32 + n * 16 + fq * 4;
                        *(u32x2*)(k + (col >> 7) * 192 + (col & 127)) = pack4(acc[ai][bj][m][n] * rstd);
                    }
            } else {
                bf16_t* vt = (bf16_t*)J.o0 + (size_t)row * MT;
#pragma unroll
                for (int bj = 0; bj < 2; ++bj)
#pragma unroll
                    for (int n = 0; n < 2; ++n) {
                        const int col = bcol + bj * HALF + wc * 32 + n * 16 + fq * 4;
                        f32x4 v = acc[ai][bj][m][n];
                        if (J.i0) {
#pragma unroll
                            for (int j = 0; j < 4; ++j) {
                                f32x4 a = *(const f32x4*)(J.f0 + (size_t)(col + j) * 16 + 8);
                                v[j] *= rsqrtf((a[0] + a[1] + a[2] + a[3]) * (1.0f / 256.0f) + EPSV);
                            }
                        }
                        *(u32x2*)(vt + col) = pack4(v);
                    }
            }
            __builtin_amdgcn_sched_barrier(0);
        }
}

DI void gemm_run(const GemmJob& J, char* lds, const int tid_in, const int rot) {
    bf16_t* shm = (bf16_t*)lds;
    const int lda = J.lda, ldb = J.ldb, ksplit = J.ksplit;
    const __amdgpu_buffer_rsrc_t rs_A = __builtin_amdgcn_make_buffer_rsrc((void*)J.A, 0, 0x7fffffff, 0x00020000);
    const __amdgpu_buffer_rsrc_t rs_Bt = __builtin_amdgcn_make_buffer_rsrc((void*)J.B, 0, 0x7fffffff, 0x00020000);
#define SA(b, h) (shm + ((b) * 2 + (h)) * HT)
#define SB(b, h) (shm + (4 + (b) * 2 + (h)) * HT)
#define STAGE(P, BASE, OFF, LD, br, kt) do { const int _so = ((br) * (LD) + (kt) * BK) * 2 + kbyte; \
    for (int _i = 0; _i < 2; ++_i) { \
      __builtin_amdgcn_raw_ptr_buffer_load_lds(rs_##BASE, \
        (__attribute__((address_space(3))) unsigned*)((char*)(P) + tid_in * 1024 + _i * 8192), 16, OFF[_i], _so, 0, 0); } } while (0)
#define LDA(dst, b, h) for (int m = 0; m < 4; ++m) for (int k = 0; k < 2; ++k) \
    dst[m][k] = *reinterpret_cast<const bf16x8*>((char*)SA(b, h) + lds_byte(wr * 64 + m * 16 + fr, k * 32 + fq * 8))
#define LDB(dst, b, h) for (int n = 0; n < 2; ++n) for (int k = 0; k < 2; ++k) \
    dst[n][k] = *reinterpret_cast<const bf16x8*>((char*)SB(b, h) + lds_byte(wc * 32 + n * 16 + fr, k * 32 + fq * 8))
#define MMA(ai, bj, At_, Bt_) do { __builtin_amdgcn_s_setprio(1); \
    for (int m = 0; m < 4; ++m) for (int n = 0; n < 2; ++n) for (int k = 0; k < 2; ++k) \
      acc[ai][bj][m][n] = __builtin_amdgcn_mfma_f32_16x16x32_bf16(Bt_[n][k], At_[m][k], acc[ai][bj][m][n], 0, 0, 0); \
    __builtin_amdgcn_s_setprio(0); } while (0)
#define WAIT_V(n) asm volatile("s_waitcnt vmcnt(" #n ")" ::: "memory")
#define WAIT_L(n) asm volatile("s_waitcnt lgkmcnt(" #n ")" ::: "memory")
#define BAR __builtin_amdgcn_s_barrier()
#define SCHED __builtin_amdgcn_sched_barrier(0)
    const int nM = J.M / BM, nN = J.N / BM, nwg = nM * nN * J.ksplit;
    const int nt = J.K / J.ksplit / BK;
    for (int it = 0;; ++it) {
        int cshift = (int)blockIdx.x - rot; if (cshift < 0) cshift += gridDim.x;
        const long L = (long)it * gridDim.x + cshift;
        if (L >= nwg) break;
        const int tid = fresh_tid(tid_in);
        const int wid = tid >> 6, lane = tid & 63, wr = wid >> 2, wc = wid & 3, fr = lane & 15, fq = lane >> 4;
        unsigned offA[2], offB[2];
#pragma unroll
        for (int i = 0; i < 2; ++i) { int r_, c_; stage_rc(tid * 16 + i * 8192, r_, c_); offA[i] = (unsigned)(r_ * lda + c_) * 2u; offB[i] = (unsigned)(r_ * ldb + c_) * 2u; }
        int pm, pn, kbyte = 0, ksel = 0;
        if (ksplit > 1) {
            const int tile = (int)L / ksplit, ks = (int)L % ksplit; ksel = ks;
            pm = tile % nM; pn = tile / nM;
            kbyte = ks * (J.K / ksplit) * 2;
        } else {
            int wgid = (int)L;
            { const int q = nwg / 8, r = nwg % 8, xcd = wgid % 8, off = wgid / 8; wgid = (xcd < r ? xcd * (q + 1) : r * (q + 1) + (xcd - r) * q) + off; }
            const int nig = 8 * nN, gid = wgid / nig, fm = gid * 8, gsz = (nM - fm) < 8 ? (nM - fm) : 8;
            pm = fm + ((wgid % nig) % gsz); pn = (wgid % nig) / gsz;
        }
        const int brow = pm * BM, bcol = pn * BM;
        f32x4 acc[2][2][4][2];
#pragma unroll
        for (int a = 0; a < 2; ++a)
#pragma unroll
            for (int b = 0; b < 2; ++b)
#pragma unroll
                for (int m = 0; m < 4; ++m)
#pragma unroll
                    for (int n = 0; n < 2; ++n) acc[a][b][m][n] = (f32x4){0.f, 0.f, 0.f, 0.f};
        bf16x8 At[4][2], B0[2][2], B1[2][2];
        WAIT_V(0);
        STAGE(SB(0, 0), Bt, offB, ldb, bcol, 0); STAGE(SA(0, 0), A, offA, lda, brow, 0);
        STAGE(SB(0, 1), Bt, offB, ldb, bcol + HALF, 0); STAGE(SA(0, 1), A, offA, lda, brow + HALF, 0);
        if (wr == 1) BAR;
        WAIT_V(4); BAR;
        STAGE(SB(1, 0), Bt, offB, ldb, bcol, 1); STAGE(SA(1, 0), A, offA, lda, brow, 1); STAGE(SB(1, 1), Bt, offB, ldb, bcol + HALF, 1);
        WAIT_V(6); BAR;
        for (int t = 0; t < nt - 2; t += 2) {
            LDB(B0, 0, 0); SCHED; LDA(At, 0, 0); STAGE(SA(1, 1), A, offA, lda, brow + HALF, t + 1);
            WAIT_L(8); BAR; WAIT_L(0); MMA(0, 0, At, B0); BAR; SCHED;
            LDB(B1, 0, 1); STAGE(SB(0, 0), Bt, offB, ldb, bcol, t + 2);
            BAR; WAIT_L(0); MMA(0, 1, At, B1); BAR;
            LDA(At, 0, 1); STAGE(SA(0, 0), A, offA, lda, brow, t + 2);
            BAR; WAIT_L(0); MMA(1, 0, At, B0); BAR; SCHED;
            STAGE(SB(0, 1), Bt, offB, ldb, bcol + HALF, t + 2);
            WAIT_V(6); BAR; MMA(1, 1, At, B1); BAR;
            LDB(B0, 1, 0); SCHED; LDA(At, 1, 0); STAGE(SA(0, 1), A, offA, lda, brow + HALF, t + 2);
            WAIT_L(8); BAR; WAIT_L(0); MMA(0, 0, At, B0); BAR; SCHED;
            LDB(B1, 1, 1); STAGE(SB(1, 0), Bt, offB, ldb, bcol, t + 3);
            BAR; WAIT_L(0); MMA(0, 1, At, B1); BAR;
            LDA(At, 1, 1); STAGE(SA(1, 0), A, offA, lda, brow, t + 3);
            BAR; WAIT_L(0); MMA(1, 0, At, B0); BAR; SCHED;
            STAGE(SB(1, 1), Bt, offB, ldb, bcol + HALF, t + 3);
            WAIT_V(6); BAR; MMA(1, 1, At, B1); BAR;
        }
        { LDB(B0, 0, 0); LDA(At, 0, 0); STAGE(SA(1, 1), A, offA, lda, brow + HALF, nt - 1);
          BAR; WAIT_L(0); MMA(0, 0, At, B0); BAR;
          LDB(B1, 0, 1); BAR; WAIT_L(0); MMA(0, 1, At, B1); BAR;
          LDA(At, 0, 1); WAIT_V(4); BAR; WAIT_L(0); MMA(1, 0, At, B0); MMA(1, 1, At, B1); BAR; }
        { LDB(B0, 1, 0); LDA(At, 1, 0); WAIT_V(2); BAR; WAIT_L(0); MMA(0, 0, At, B0); BAR;
          LDB(B1, 1, 1); WAIT_V(0); BAR; WAIT_L(0); MMA(0, 1, At, B1); BAR;
          LDA(At, 1, 1); BAR; WAIT_L(0); MMA(1, 0, At, B0); MMA(1, 1, At, B1); BAR; }
        if (wr == 0) BAR;
        { const int tid2 = fresh_tid(tid_in);
          const int wid2 = tid2 >> 6, lane2 = tid2 & 63;
          gemm_epilogue(J, acc, brow + J.row0, bcol, wid2 >> 2, wid2 & 3, lane2 & 15, lane2 >> 4, ksel); }
    }
#undef SA
#undef SB
}

struct AttnArgs {
    const bf16_t* q; int q_ts, q_hs, q_rot, q_plain;
    const bf16_t* k; int k_ts, k_hs;
    const bf16_t* vt; bf16_t* ao;
    int NH; int ctx_units; float scale;
    const float* sink; const float* rpb; const float* lamp; const float* ng; float lam_init;
};

DI int crow(int i, int h) { return (i & 3) + 8 * (i >> 2) + 4 * h; }

template <int DQK, int DV, int MODE, bool PAIR>
DI void attn_phase(const AttnArgs& a, char* lds, const int tid) {
    constexpr int KW = PAIR ? 128 : DQK;
    constexpr int KST = KW * 2 + 16;
    constexpr int VST = 136;
    constexpr int KBYTES = 64 * KST, VBYTES = DV * VST, BUF = KBYTES + VBYTES;
    constexpr int QB = PAIR ? 128 : 256;
    constexpr int NQB = 4096 / QB;
    constexpr int NS = DQK / 16, NDB = DV / 32;
    constexpr int KCH = (64 * KW * 2 / 16) / NTHREADS;
    constexpr int VCH = (DV * 128 / 16) / NTHREADS;
    constexpr int NOPE = DQK - 64;
    static_assert(2 * BUF <= 120 * 1024, "lds");
    const int wave = tid >> 6, lane = tid & 63, r = lane & 31, h = lane >> 5;
    const int x32 = (lane ^ 32) << 2;
    const int wq = PAIR ? (wave & 3) : wave, gsel = PAIR ? (wave >> 2) : 0;
    const int koff = gsel * 64;
    const float cs = a.scale * LOG2E;
    float* rpbL = (float*)(lds + 122880);
    const int n_lat = 4 * a.NH * NQB;
    const int n_units = n_lat + (a.ctx_units ? 4 * a.NH : 0);
    float lam = 0.f;
    if (PAIR) {
        float p0 = a.lamp[lane] * a.lamp[64 + lane], p1 = a.lamp[128 + lane] * a.lamp[192 + lane];
        p0 = wave_sum(p0, lane); p1 = wave_sum(p1, lane);
        lam = __expf(p0) - __expf(p1) + a.lam_init;
    }
    for (int u = blockIdx.x; u < n_units; u += gridDim.x) {
        const bool isctx = u >= n_lat;
        int b, hh, qb;
        if (!isctx) { qb = u % NQB; hh = (u / NQB) % a.NH; b = u / (NQB * a.NH); }
        else { const int v = u - n_lat; qb = 0; hh = v % a.NH; b = v / a.NH; }
        const int tokq0 = isctx ? (NLAT + b * 256) : (b * 4096 + qb * QB);
        const int tokq = tokq0 + wq * 32 + r;
        const int qhead = PAIR ? 2 * hh + gsel : hh;
        const int kvhead = (MODE == 1) ? (hh >> 2) : hh;
        const bf16_t* qp = a.q + (size_t)tokq * a.q_ts + qhead * a.q_hs;
        const bf16_t* kbase = a.k + kvhead * a.k_hs;
        const bf16_t* vbase = a.vt + (size_t)(kvhead * DV) * MT;
        int tlo = 0, thi = 0;
        if (!isctx) {
            if (MODE == 0) { tlo = 0; thi = 64; }
            else if (MODE == 1) { const int q0 = qb * QB; tlo = (q0 - 128) < 0 ? 0 : (q0 - 128) >> 6; thi = (q0 + QB + 128) >> 6; if (thi > 64) thi = 64; }
            else { const int r0 = qb * 4; int lo = r0 - 4; lo = lo < 0 ? 0 : (lo > 56 ? 56 : lo); int hi2 = r0 + 3 - 4; hi2 = hi2 < 0 ? 0 : (hi2 > 56 ? 56 : hi2); tlo = lo; thi = hi2 + 8; }
        }
        const int T = 4 + (thi - tlo);
        if (MODE == 2) {
            for (int i = tid; i < 465; i += NTHREADS) rpbL[i] = a.rpb[hh * 465 + i];
        }
        const int qpos = qb * QB + wq * 32 + r;
        const int qrow = qpos >> 6, qcol = qpos & 63;
        int cstart = qcol - 8; cstart = cstart < 0 ? 0 : (cstart > 48 ? 48 : cstart);
        int rstart = qrow - 4; rstart = rstart < 0 ? 0 : (rstart > 56 ? 56 : rstart);

        constexpr bool D2 = (KCH + VCH) <= 4;
        constexpr int NSET = D2 ? 2 : 1;
        u32x4 kreg[NSET][KCH], vreg[NSET][VCH];
        const __amdgpu_buffer_rsrc_t rs_k = __builtin_amdgcn_make_buffer_rsrc((void*)kbase, 0, 0x7fffffff, 0x00020000);
        const __amdgpu_buffer_rsrc_t rs_v = __builtin_amdgcn_make_buffer_rsrc((void*)vbase, 0, 0x7fffffff, 0x00020000);
        auto tile_tok = [&](int t) { return t < 4 ? (NLAT + b * 256 + t * 64) : (b * 4096 + (tlo + t - 4) * 64); };
        auto load_tile = [&](int t, const int set) __attribute__((always_inline)) {
            const int tok = tile_tok(t);
#pragma unroll
            for (int c = 0; c < KCH; ++c) { const int idx = tid + c * NTHREADS, row = idx / (KW / 8), ch = idx % (KW / 8);
                kreg[set][c] = __builtin_amdgcn_raw_buffer_load_b128(rs_k, (row * a.k_ts + ch * 8) * 2, tok * a.k_ts * 2, 0); }
#pragma unroll
            for (int c = 0; c < VCH; ++c) { const int idx = tid + c * NTHREADS, row = idx >> 3, ch = idx & 7;
                vreg[set][c] = __builtin_amdgcn_raw_buffer_load_b128(rs_v, (row * MT + ch * 8) * 2, tok * 2, 0); }
        };
        auto store_tile = [&](int buf, const int set) __attribute__((always_inline)) {
            char* kb = lds + buf * BUF; char* vb = kb + KBYTES;
#pragma unroll
            for (int c = 0; c < KCH; ++c) { const int idx = tid + c * NTHREADS, row = idx / (KW / 8), ch = idx % (KW / 8);
                *(u32x4*)(kb + row * KST + ch * 16) = kreg[set][c]; }
#pragma unroll
            for (int c = 0; c < VCH; ++c) { const int idx = tid + c * NTHREADS, row = idx >> 3, ch = idx & 7;
                u32x2 w0 = {vreg[set][c].x, vreg[set][c].y}, w1 = {vreg[set][c].z, vreg[set][c].w};
                *(u32x2*)(vb + row * VST + ch * 16) = w0; *(u32x2*)(vb + row * VST + ch * 16 + 8) = w1; }
        };
        bf16x8 qf[NS];
        auto load_q = [&](bool lat) {
#pragma unroll
            for (int s = 0; s < NS; ++s) {
                const int off = (s * 16 < NOPE) ? s * 16 : ((lat ? a.q_rot : a.q_plain) + s * 16 - NOPE);
                qf[s] = *(const bf16x8*)(qp + off + 8 * h);
            }
        };
        f32x16 ot[NDB];
#pragma unroll
        for (int d = 0; d < NDB; ++d)
#pragma unroll
            for (int i = 0; i < 16; ++i) ot[d][i] = 0.f;
        float m_run = -1e30f, l_run = 0.f;

        load_tile(0, 0); store_tile(0, 0);
        if (D2) load_tile(T > 1 ? 1 : 0, 1);
        load_q(false);
        __syncthreads();
        auto tile_body = [&](const int t, const bool LAT, const int PAR) __attribute__((always_inline)) {
            if (D2) load_tile(t + 2 < T ? t + 2 : T - 1, PAR);
            else load_tile(t + 1 < T ? t + 1 : T - 1, 0);
            const char* kb_l = lds + (t & 1) * BUF; const char* vb_l = kb_l + KBYTES;
            bool skip = false;
            const int kt = tlo + t - 4;
            if (LAT) {
                if (MODE == 1) { const int ts = kt * 64, qw = qb * QB + wq * 32; skip = (ts + 63 < qw - 128) || (ts > qw + 31 + 128); }
                if (MODE == 2) { skip = (kt < rstart) || (kt >= rstart + 8); }
            }
            if (!skip) {
              if constexpr (DQK == 64) {
                constexpr int G = (NS <= 4) ? NS : 6;
                constexpr bool VBOTH = (DV == 64);
                f32x16 st[2];
#pragma unroll
                for (int i = 0; i < 16; ++i) { st[0][i] = 0.f; st[1][i] = 0.f; }
#pragma unroll
                for (int g0 = 0; g0 < NS; g0 += G) {
                    bf16x8 ka[G], kc[G];
#pragma unroll
                    for (int s = 0; s < G; ++s) {
                        ka[s] = *(const bf16x8*)(kb_l + r * KST + (koff + 8 * h) * 2 + (g0 + s) * 32);
                        kc[s] = *(const bf16x8*)(kb_l + (32 + r) * KST + (koff + 8 * h) * 2 + (g0 + s) * 32);
                    }
                    __builtin_amdgcn_sched_barrier(0);
#pragma unroll
                    for (int s = 0; s < G; ++s) {
                        st[0] = __builtin_amdgcn_mfma_f32_32x32x16_bf16(ka[s], qf[g0 + s], st[0], 0, 0, 0);
                        st[1] = __builtin_amdgcn_mfma_f32_32x32x16_bf16(kc[s], qf[g0 + s], st[1], 0, 0, 0);
                    }
                }
                s16x4 vlo[VBOTH ? 2 : 1][2][NDB], vhi[VBOTH ? 2 : 1][2][NDB];
#pragma unroll
                for (int kb = 0; kb < (VBOTH ? 2 : 1); ++kb)
#pragma unroll
                    for (int s2 = 0; s2 < 2; ++s2)
#pragma unroll
                        for (int d = 0; d < NDB; ++d) {
                            const char* vp = vb_l + (32 * d + r) * VST + (32 * kb + 16 * s2 + 4 * h) * 2;
                            vlo[kb][s2][d] = *(const s16x4*)vp; vhi[kb][s2][d] = *(const s16x4*)(vp + 16);
                        }
                __builtin_amdgcn_sched_barrier(0);
                const bool MASKED = (MODE != 0) && LAT;
                float mx = -3e38f;
                if (MASKED) {
#pragma unroll
                    for (int kb = 0; kb < 2; ++kb)
#pragma unroll
                        for (int i = 0; i < 16; ++i) {
                            float tv = st[kb][i] * cs;
                            if (MODE == 1) {
                                const int d = kt * 64 + 32 * kb + crow(i, h) - qpos; const bool valid = (d <= 128) && (d >= -128); tv = valid ? tv : -1e30f;
                            } else if (MODE == 2) {
                                const int kc2 = 32 * kb + crow(i, h);
                                const bool valid = (kc2 >= cstart) && (kc2 < cstart + 16);
                                int bi = (kt - qrow + 7) * 31 + (kc2 - qcol + 15); bi = valid ? bi : 0;
                                const float bias = rpbL[bi];
                                tv = valid ? (tv + bias * LOG2E) : -1e30f;
                            }
                            st[kb][i] = tv; mx = fmaxf(mx, tv);
                        }
                } else {
#pragma unroll
                    for (int kb = 0; kb < 2; ++kb)
#pragma unroll
                        for (int i = 0; i < 16; ++i) mx = fmaxf(mx, st[kb][i]);
                    mx *= cs;
                }
                mx = max_x32(mx);
                if (__any(mx - m_run > RESCALE_THR)) {
                    const float m_up = fmaxf(m_run, mx);
                    const float alpha = fexp2(m_run - m_up);
                    l_run *= alpha;
#pragma unroll
                    for (int d = 0; d < NDB; ++d)
#pragma unroll
                        for (int i = 0; i < 16; ++i) ot[d][i] *= alpha;
                    m_run = m_up;
                }
                const float m_new = m_run;
                float rs = 0.f;
#pragma unroll
                for (int kb = 0; kb < 2; ++kb)
#pragma unroll
                    for (int i = 0; i < 16; ++i) {
                        const float p = MASKED ? fexp2(st[kb][i] - m_new) : fexp2(__builtin_fmaf(st[kb][i], cs, -m_new));
                        st[kb][i] = p; rs += p;
                    }
                l_run += rs;
#pragma unroll
                for (int kb = 0; kb < 2; ++kb) {
                    if (!VBOTH && kb == 1) {
#pragma unroll
                        for (int s2 = 0; s2 < 2; ++s2)
#pragma unroll
                            for (int d = 0; d < NDB; ++d) {
                                const char* vp = vb_l + (32 * d + r) * VST + (32 + 16 * s2 + 4 * h) * 2;
                                vlo[0][s2][d] = *(const s16x4*)vp; vhi[0][s2][d] = *(const s16x4*)(vp + 16);
                            }
                    }
                    const int vs = VBOTH ? kb : 0;
#pragma unroll
                    for (int s2 = 0; s2 < 2; ++s2) {
                        u32x4 pw;
                        pw.x = pack2(st[kb][8 * s2 + 0], st[kb][8 * s2 + 1]); pw.y = pack2(st[kb][8 * s2 + 2], st[kb][8 * s2 + 3]);
                        pw.z = pack2(st[kb][8 * s2 + 4], st[kb][8 * s2 + 5]); pw.w = pack2(st[kb][8 * s2 + 6], st[kb][8 * s2 + 7]);
                        const bf16x8 pf = __builtin_bit_cast(bf16x8, pw);
#pragma unroll
                        for (int d = 0; d < NDB; ++d) {
                            const bf16x8 vf = __builtin_shufflevector(vlo[vs][s2][d], vhi[vs][s2][d], 0, 1, 2, 3, 4, 5, 6, 7);
                            ot[d] = __builtin_amdgcn_mfma_f32_32x32x16_bf16(vf, pf, ot[d], 0, 0, 0);
                        }
                    }
                }
              } else {
                constexpr bool PREK = NS <= 4;
                bf16x8 kf[NS];
#pragma unroll
                for (int s = 0; s < NS; ++s) kf[s] = *(const bf16x8*)(kb_l + r * KST + (koff + 8 * h) * 2 + s * 32);
#pragma unroll
                for (int kb = 0; kb < 2; ++kb) {
                    f32x16 st;
#pragma unroll
                    for (int i = 0; i < 16; ++i) st[i] = 0.f;
                    __builtin_amdgcn_sched_barrier(0);
#pragma unroll
                    for (int s = 0; s < NS; ++s) st = __builtin_amdgcn_mfma_f32_32x32x16_bf16(kf[s], qf[s], st, 0, 0, 0);
                    s16x4 vlo[2][NDB], vhi[2][NDB];
#pragma unroll
                    for (int s2 = 0; s2 < 2; ++s2)
#pragma unroll
                        for (int d = 0; d < NDB; ++d) {
                            const char* vp = vb_l + (32 * d + r) * VST + (32 * kb + 16 * s2 + 4 * h) * 2;
                            vlo[s2][d] = *(const s16x4*)vp; vhi[s2][d] = *(const s16x4*)(vp + 16);
                        }
                    if (kb == 0) {
                        if (PREK) {
#pragma unroll
                            for (int s = 0; s < NS; ++s) kf[s] = *(const bf16x8*)(kb_l + (32 + r) * KST + (koff + 8 * h) * 2 + s * 32);
                        }
                    }
                    __builtin_amdgcn_sched_barrier(0);
                    const bool MASKED = (MODE != 0) && LAT;
                    float mx = -3e38f;
                    if (MASKED) {
#pragma unroll
                        for (int i = 0; i < 16; ++i) {
                            float tv = st[i] * cs;
                            if (MODE == 1) {
                                const int d = kt * 64 + 32 * kb + crow(i, h) - qpos; const bool valid = (d <= 128) && (d >= -128); tv = valid ? tv : -1e30f;
                            } else if (MODE == 2) {
                                const int kc = 32 * kb + crow(i, h);
                                const bool valid = (kc >= cstart) && (kc < cstart + 16);
                                int bi = (kt - qrow + 7) * 31 + (kc - qcol + 15); bi = valid ? bi : 0;
                                const float bias = rpbL[bi];
                                tv = valid ? (tv + bias * LOG2E) : -1e30f;
                            }
                            st[i] = tv; mx = fmaxf(mx, tv);
                        }
                    } else {
#pragma unroll
                        for (int i = 0; i < 16; ++i) mx = fmaxf(mx, st[i]);
                        mx *= cs;
                    }
                    mx = max_x32(mx);
                    if (__any(mx - m_run > RESCALE_THR)) {
                        const float m_up = fmaxf(m_run, mx);
                        const float alpha = fexp2(m_run - m_up);
                        l_run *= alpha;
#pragma unroll
                        for (int d = 0; d < NDB; ++d)
#pragma unroll
                            for (int i = 0; i < 16; ++i) ot[d][i] *= alpha;
                        m_run = m_up;
                    }
                    const float m_new = m_run;
                    float rs = 0.f;
                    if (MASKED) {
#pragma unroll
                        for (int i = 0; i < 16; ++i) { const float p = fexp2(st[i] - m_new); st[i] = p; rs += p; }
                    } else {
#pragma unroll
                        for (int i = 0; i < 16; ++i) { const float p = fexp2(__builtin_fmaf(st[i], cs, -m_new)); st[i] = p; rs += p; }
                    }
                    l_run += rs;
#pragma unroll
                    for (int s2 = 0; s2 < 2; ++s2) {
                        u32x4 pw;
                        pw.x = pack2(st[8 * s2 + 0], st[8 * s2 + 1]); pw.y = pack2(st[8 * s2 + 2], st[8 * s2 + 3]);
                        pw.z = pack2(st[8 * s2 + 4], st[8 * s2 + 5]); pw.w = pack2(st[8 * s2 + 6], st[8 * s2 + 7]);
                        const bf16x8 pf = __builtin_bit_cast(bf16x8, pw);
#pragma unroll
                        for (int d = 0; d < NDB; ++d) {
                            const bf16x8 vf = __builtin_shufflevector(vlo[s2][d], vhi[s2][d], 0, 1, 2, 3, 4, 5, 6, 7);
                            ot[d] = __builtin_amdgcn_mfma_f32_32x32x16_bf16(vf, pf, ot[d], 0, 0, 0);
                        }
                    }
                    if (kb == 0) {
                        if (!PREK) {
#pragma unroll
                            for (int s = 0; s < NS; ++s) kf[s] = *(const bf16x8*)(kb_l + (32 + r) * KST + (koff + 8 * h) * 2 + s * 32);
                        }
                    }
                }
              }
            }
            store_tile((t + 1) & 1, D2 ? (PAR ^ 1) : 0);
            __syncthreads();
        };
        for (int t = 0; t < 4; t += 2) { tile_body(t, false, 0); tile_body(t + 1, false, 1); }
        if (T > 4) {
            load_q(true);
            for (int t = 4; t < T; t += 2) { tile_body(t, true, 0); if (t + 1 < T) tile_body(t + 1, true, 1); }
        }
        float l_tot = l_run + bperm(l_run, x32);
        if (MODE == 1) l_tot += fexp2(a.sink[hh] * LOG2E - m_run);
        const float inv = 1.0f / l_tot;
        if (!PAIR) {
            bf16_t* op = a.ao + (size_t)tokq * 1024 + hh * DV;
#pragma unroll
            for (int d = 0; d < NDB; ++d)
#pragma unroll
                for (int g = 0; g < 4; ++g) {
                    f32x4 v = {ot[d][4 * g] * inv, ot[d][4 * g + 1] * inv, ot[d][4 * g + 2] * inv, ot[d][4 * g + 3] * inv};
                    *(u32x2*)(op + 32 * d + 8 * g + 4 * h) = pack4(v);
                }
        } else {
            float* ex = (float*)lds;
            if (gsel == 1) {
#pragma unroll
                for (int d = 0; d < NDB; ++d)
#pragma unroll
                    for (int i = 0; i < 16; ++i) ex[(wq * 128 + 32 * d + crow(i, h)) * 32 + r] = ot[d][i] * inv;
            }
            __syncthreads();
            if (gsel == 0) {
                float ss = 0.f;
#pragma unroll
                for (int d = 0; d < NDB; ++d)
#pragma unroll
                    for (int i = 0; i < 16; ++i) {
                        const float o1 = ex[(wq * 128 + 32 * d + crow(i, h)) * 32 + r];
                        const float v = ot[d][i] * inv - lam * o1;
                        ot[d][i] = v; ss += v * v;
                    }
                ss += bperm(ss, x32);
                const float rstd = rsqrtf(ss * (1.0f / 128.0f) + EPSV) * (1.0f - a.lam_init);
                bf16_t* op = a.ao + (size_t)tokq * 1024 + hh * DV;
#pragma unroll
                for (int d = 0; d < NDB; ++d)
#pragma unroll
                    for (int g = 0; g < 4; ++g) {
                        const int dd = 32 * d + 8 * g + 4 * h;
                        f32x4 gn = *(const f32x4*)(a.ng + dd);
                        f32x4 v = {ot[d][4 * g] * rstd * gn[0], ot[d][4 * g + 1] * rstd * gn[1], ot[d][4 * g + 2] * rstd * gn[2], ot[d][4 * g + 3] * rstd * gn[3]};
                        *(u32x2*)(op + dd) = pack4(v);
                    }
            }
            __syncthreads();
        }
    }
}

DI void norm_phase(float* X, const float* g, const float* mods_l, int shift_i, int scale_i, bf16_t* H, int nrows, const int tid, const float* part, int npart) {
    const int wave = tid >> 6, lane = tid & 63;
    const int gw = blockIdx.x * 8 + wave, nw = gridDim.x * 8;
    for (int row = gw; row < nrows; row += nw) {
        float* xp = X + (size_t)row * DM;
        f32x4 v[4]; float ss = 0.f;
#pragma unroll
        for (int i = 0; i < 4; ++i) v[i] = *(const f32x4*)(xp + i * 256 + lane * 4);
        if (row >= NLAT && npart > 0) {
            for (int sidx = 0; sidx < npart; ++sidx) {
                const float* pp = part + ((size_t)sidx * (MT - NLAT) + (row - NLAT)) * DM;
#pragma unroll
                for (int i = 0; i < 4; ++i) v[i] += *(const f32x4*)(pp + i * 256 + lane * 4);
            }
#pragma unroll
            for (int i = 0; i < 4; ++i) *(f32x4*)(xp + i * 256 + lane * 4) = v[i];
        }
#pragma unroll
        for (int i = 0; i < 4; ++i) ss += v[i][0] * v[i][0] + v[i][1] * v[i][1] + v[i][2] * v[i][2] + v[i][3] * v[i][3];
        ss = wave_sum(ss, lane);
        const float rstd = rsqrtf(ss * (1.0f / 1024.0f) + EPSV);
        const float* mp = mods_l + (size_t)mod_row(row) * 9216;
#pragma unroll
        for (int i = 0; i < 4; ++i) {
            const int col = i * 256 + lane * 4;
            f32x4 gg = *(const f32x4*)(g + col), sh = *(const f32x4*)(mp + shift_i * 1024 + col), sc = *(const f32x4*)(mp + scale_i * 1024 + col);
            f32x4 y = (v[i] * rstd) * gg;
            y = y * (sc + 1.0f) + sh;
            *(u32x2*)(H + (size_t)row * DM + col) = pack4(y);
        }
    }
}

DI void final_phase(const float* X, const float* g, float* out, const int tid) {
    const int wave = tid >> 6, lane = tid & 63;
    const int gw = blockIdx.x * 8 + wave, nw = gridDim.x * 8;
    for (int row = gw; row < NLAT; row += nw) {
        const float* xp = X + (size_t)row * DM;
        f32x4 v[4]; float ss = 0.f;
#pragma unroll
        for (int i = 0; i < 4; ++i) { v[i] = *(const f32x4*)(xp + i * 256 + lane * 4); ss += v[i][0] * v[i][0] + v[i][1] * v[i][1] + v[i][2] * v[i][2] + v[i][3] * v[i][3]; }
        ss = wave_sum(ss, lane);
        const float rstd = rsqrtf(ss * (1.0f / 1024.0f) + EPSV);
#pragma unroll
        for (int i = 0; i < 4; ++i) {
            const int col = i * 256 + lane * 4;
            f32x4 gg = *(const f32x4*)(g + col);
            *(f32x4*)(out + (size_t)row * DM + col) = (v[i] * rstd) * gg;
        }
    }
}

struct ConvJob { const float* src; int srcN, K, dstN, mode, coloff; const float* scale; size_t dst; };

DI int rope_dim(int w, int grp) { return (w < 16) ? grp * 16 + w : 32 + grp * 16 + (w - 16); }
DI int conv_perm(int mode, int coloff, int n) {
    switch (mode) {
    case 0: return coloff + n;
    case 1: { const int t = n >> 8, q = n & 255, bj = q >> 7, wcc = (q & 127) >> 5, nn = (q & 31) >> 4, i = q & 15;
              return (bj ? 2816 : 0) + t * 128 + wcc * 32 + (i >> 2) * 8 + nn * 4 + (i & 3); }
    case 2: { const int blk = n >> 6, grp = (n >> 5) & 1, w = n & 31; return coloff + blk * 64 + rope_dim(w, grp); }
    case 3: { if (n < 768) return n; if (n >= 832) return -1; const int rr = n - 768; return 768 + rope_dim(rr & 31, rr >> 5); }
    case 4: { const int g = n >> 5, head = g / 6, gi = g - head * 6, w = n & 31; if (gi < 4) return head * 192 + gi * 32 + w; return head * 192 + 128 + rope_dim(w, gi - 4); }
    case 5: return (n >> 7) * 256 + (n & 127);
    default: return (n >> 7) * 256 + 128 + (n & 127);
    }
}

DI ConvJob get_conv_job(const Params& p, int j) {
    ConvJob c; c.scale = nullptr; c.coloff = 0; c.mode = 0; c.K = 1024; c.srcN = 1024; c.dstN = 1024;
    if (j < 8) { c.src = p.in[8] + (size_t)j * 1024 * 5632; c.srcN = 5632; c.dstN = 5632; c.mode = 1; c.dst = W_IN + (size_t)j * 5632 * 1024; }
    else if (j < 16) { c.src = p.in[9] + (size_t)(j - 8) * 2816 * 1024; c.K = 2816; c.dst = W_OUT + (size_t)(j - 8) * 1024 * 2816; }
    else switch (j) {
    case 16: c.src = p.in[10]; c.srcN = 832; c.mode = 3; c.dst = W_MLA_DOWN; break;
    case 17: c.src = p.in[13]; c.srcN = 1536; c.K = 512; c.dstN = 1536; c.mode = 4; c.scale = p.in[11]; c.dst = W_MLA_UQ; break;
    case 18: c.src = p.in[14]; c.srcN = 2048; c.K = 256; c.mode = 5; c.scale = p.in[12]; c.dst = W_MLA_UK; break;
    case 19: c.src = p.in[14]; c.srcN = 2048; c.K = 256; c.mode = 6; c.scale = p.in[12]; c.dst = W_MLA_UV; break;
    case 20: c.src = p.in[15]; c.dst = W_MLA_WO; break;
    case 21: c.src = p.in[16]; c.srcN = 1536; c.dstN = 1280; c.mode = 2; c.dst = W_SWA_QK; break;
    case 22: c.src = p.in[16]; c.srcN = 1536; c.dstN = 256; c.coloff = 1280; c.dst = W_SWA_V; break;
    case 23: c.src = p.in[18]; c.dst = W_SWA_WO; break;
    case 24: c.src = p.in[19]; c.srcN = 3072; c.dstN = 2048; c.dst = W_NA_QK; break;
    case 25: c.src = p.in[19]; c.srcN = 3072; c.coloff = 2048; c.dst = W_NA_V; break;
    case 26: c.src = p.in[21]; c.dst = W_NA_WO; break;
    case 27: c.src = p.in[22]; c.srcN = 3072; c.dstN = 2048; c.mode = 2; c.dst = W_DIFF_QK; break;
    case 28: c.src = p.in[22]; c.srcN = 3072; c.coloff = 2048; c.dst = W_DIFF_V; break;
    default: c.src = p.in[25]; c.dst = W_DIFF_WO; break;
    }
    return c;
}
constexpr int N_CONV = 30;

DI void prep_phase(const Params& p, char* lds, const int tid) {
    bf16_t* W = (bf16_t*)(p.ws + OFF_W);
    {
        constexpr int TST = 528;
        int rot = 0;
        for (int j = 0; j < N_CONV; ++j) {
            const ConvJob c = get_conv_job(p, j);
            const int nkt = c.K / 256, units = (c.dstN / 64) * nkt;
            int first = (int)blockIdx.x - rot; if (first < 0) first += gridDim.x;
            for (int u = first; u < units; u += gridDim.x) {
                const int ntile = u / nkt, kt = u % nkt;
                const int nl = tid & 63, kk = tid >> 6;
                const int sc = conv_perm(c.mode, c.coloff, ntile * 64 + nl);
                const int k0 = kt * 256 + kk * 32;
                float v[32];
#pragma unroll
                for (int i = 0; i < 32; ++i) v[i] = (sc >= 0) ? c.src[(size_t)(k0 + i) * c.srcN + sc] : 0.f;
                if (c.scale) {
#pragma unroll
                    for (int i = 0; i < 32; ++i) v[i] *= c.scale[k0 + i];
                }
#pragma unroll
                for (int i = 0; i < 16; ++i) *(unsigned*)(lds + nl * TST + (kk * 32 + 2 * i) * 2) = pack2(v[2 * i], v[2 * i + 1]);
                __syncthreads();
#pragma unroll
                for (int i = 0; i < 4; ++i) {
                    const int idx = tid + i * NTHREADS, n = idx >> 5, ch = idx & 31;
                    u32x4 w = *(const u32x4*)(lds + n * TST + ch * 16);
                    *(u32x4*)(W + c.dst + (size_t)(ntile * 64 + n) * c.K + kt * 256 + ch * 8) = w;
                }
                __syncthreads();
            }
            rot = (rot + units) % (int)gridDim.x;
        }
    }
    {
        float* sc = (float*)lds;
        float* red = (float*)(lds + 20480);
        for (int i = tid; i < 5 * 1024; i += NTHREADS) {
            const int rr = i >> 10, k = i & 1023;
            const float cv = rr < 4 ? p.in[1][rr * 1024 + k] : p.in[3][k];
            sc[i] = siluf(cv);
        }
        __syncthreads();
        float* mods = (float*)(p.ws + OFF_MODS);
        const int c4 = tid & 31, ks = tid >> 5;
        for (int u = blockIdx.x; u < 4 * 72; u += gridDim.x) {
            const int l = u / 72, n0 = (u % 72) * 128;
            const float* wp = p.in[4] + (size_t)l * 1024 * 9216 + n0 + c4 * 4;
            f32x4 a0 = {0, 0, 0, 0}, a1 = a0, a2 = a0, a3 = a0, a4 = a0;
#pragma unroll 8
            for (int kk = 0; kk < 64; ++kk) {
                const int k = ks * 64 + kk;
                const f32x4 w = *(const f32x4*)(wp + (size_t)k * 9216);
                a0 += w * sc[k]; a1 += w * sc[1024 + k]; a2 += w * sc[2048 + k]; a3 += w * sc[3072 + k]; a4 += w * sc[4096 + k];
            }
            *(f32x4*)(red + (ks * 5 + 0) * 128 + c4 * 4) = a0; *(f32x4*)(red + (ks * 5 + 1) * 128 + c4 * 4) = a1;
            *(f32x4*)(red + (ks * 5 + 2) * 128 + c4 * 4) = a2; *(f32x4*)(red + (ks * 5 + 3) * 128 + c4 * 4) = a3;
            *(f32x4*)(red + (ks * 5 + 4) * 128 + c4 * 4) = a4;
            __syncthreads();
            for (int i = tid; i < 5 * 128; i += NTHREADS) {
                const int rr = i >> 7, cc = i & 127;
                float s = p.in[5][l * 9216 + n0 + cc];
#pragma unroll
                for (int q = 0; q < 16; ++q) s += red[(q * 5 + rr) * 128 + cc];
                mods[((size_t)l * 5 + rr) * 9216 + n0 + cc] = s;
            }
            __syncthreads();
        }
    }
    {
        float* cosT = (float*)(p.ws + OFF_COS); float* sinT = (float*)(p.ws + OFF_SIN);
        for (int i = blockIdx.x * NTHREADS + tid; i < 4096 * 32; i += gridDim.x * NTHREADS) {
            const int pos = i >> 5, d = i & 31, f = d & 15;
            const float inv = expf(-9.210340371976184f * (float)f / 16.0f);
            const float base = (d < 16) ? (float)(pos >> 6) : (float)(pos & 63);
            const float ang = base * inv;
            float rev = ang * 0.15915494309189535f; rev = rev - floorf(rev);
            cosT[i] = __builtin_amdgcn_cosf(rev); sinT[i] = __builtin_amdgcn_sinf(rev);
        }
    }
    {
        f32x4* X4 = (f32x4*)(p.ws + OFF_X);
        const f32x4* x4 = (const f32x4*)p.in[0]; const f32x4* c4p = (const f32x4*)p.in[2];
        const size_t nlat4 = (size_t)NLAT * 256, nall4 = (size_t)MT * 256;
        for (size_t i = (size_t)blockIdx.x * NTHREADS + tid; i < nall4; i += (size_t)gridDim.x * NTHREADS)
            X4[i] = i < nlat4 ? x4[i] : c4p[i - nlat4];
    }
}

constexpr int N_PHASES = 1 + 4 * 11 + 1;
__host__ __device__ inline bool phase_is_noop(int ph) {
    if (ph == 0 || ph == N_PHASES - 1) return false;
    const int layer = (ph - 1) / 11, slot = (ph - 1) % 11;
    return slot == 5 && layer != 0;
}

DI GemmJob get_job(const Params& p, int layer, int slot, int jidx, int& nj, const bool dry) {
    char* ws = p.ws;
    bf16_t* W = (bf16_t*)(ws + OFF_W);
    float* X = (float*)(ws + OFF_X);
    bf16_t* H = (bf16_t*)(ws + OFF_H);
    bf16_t* R = (bf16_t*)(ws + OFF_R);
    bf16_t* RQ = (bf16_t*)(ws + OFF_R + R_Q); bf16_t* RK = (bf16_t*)(ws + OFF_R + R_K);
    bf16_t* RVT = (bf16_t*)(ws + OFF_R + R_VT); bf16_t* RD = (bf16_t*)(ws + OFF_R + R_DRAW);
    const float* mods_l = (const float*)(ws + OFF_MODS) + (size_t)layer * 5 * 9216;
    float* stats = (float*)(ws + OFF_STATS);
    const float* cosT = (const float*)(ws + OFF_COS); const float* sinT = (const float*)(ws + OFF_SIN);
    const bool last = layer == 3;
    GemmJob j; j.o0 = j.o1 = nullptr; j.o2 = nullptr; j.f0 = j.f1 = nullptr; j.i0 = 0; j.s0 = 0.f; j.ksplit = 1; j.row0 = 0;
    if (slot == 1 || slot == 9) {
        const int f = slot == 1 ? 0 : 1;
        j.A = H; j.lda = 1024; j.B = W + W_IN + (size_t)(layer * 2 + f) * 5632 * 1024; j.ldb = 1024;
        j.M = (last && f == 1) ? NLAT : MT; j.N = 5632; j.K = 1024; j.epi = EPI_SWIGLU; j.o0 = R;
        nj = 1; return j;
    }
    if (slot == 2 || slot == 10) {
        const int f = slot == 2 ? 0 : 1;
        j.A = R; j.lda = DFF; j.B = W + W_OUT + (size_t)(layer * 2 + f) * 1024 * 2816; j.ldb = DFF;
        j.M = NLAT; j.N = 1024; j.K = DFF; j.epi = EPI_RESID; j.o0 = X;
        j.f0 = mods_l + (f == 0 ? 2 : 8) * 1024; j.s0 = 0.5f;
        nj = (last && f == 1) ? 1 : 2;
        if (dry) { nj = 1; j.s0 = 0.f; }
        if (jidx == 1) { j.A = R + (size_t)NLAT * DFF; j.M = MT - NLAT; j.row0 = NLAT; j.ksplit = 11; j.epi = EPI_RESID_ATOMIC; j.o2 = (float*)(ws + OFF_R + R_VT); }
        return j;
    }
    if (slot == 7) {
        const size_t wo = layer == 0 ? W_MLA_WO : layer == 1 ? W_SWA_WO : layer == 2 ? W_NA_WO : W_DIFF_WO;
        j.A = H; j.lda = 1024; j.B = W + wo; j.ldb = 1024; j.M = NLAT; j.N = 1024; j.K = 1024;
        j.epi = EPI_RESID; j.o0 = X; j.f0 = mods_l + 5 * 1024; j.s0 = 1.0f;
        nj = last ? 1 : 2;
        if (dry) { nj = 1; j.s0 = 0.f; }
        if (jidx == 1) { j.A = H + (size_t)NLAT * 1024; j.M = MT - NLAT; j.row0 = NLAT; j.ksplit = 4; j.epi = EPI_RESID_ATOMIC; j.o2 = (float*)(ws + OFF_R + R_DRAW); }
        return j;
    }
    if (slot == 4) {
        if (layer == 0) {
            j.A = H; j.lda = 1024; j.B = W + W_MLA_DOWN; j.ldb = 1024; j.M = MT; j.N = 1024; j.K = 1024;
            j.epi = EPI_MLA_DOWN; j.o0 = RD; j.o1 = RK; j.o2 = stats; j.f0 = cosT; j.f1 = sinT;
            nj = 1; return j;
        }
        j.A = H; j.lda = 1024; j.ldb = 1024; j.M = MT; j.K = 1024; j.o0 = RQ; j.o1 = RK;
        if (layer == 1) { j.B = W + W_SWA_QK; j.N = 1280; j.epi = EPI_ROPE; j.i0 = 16; j.f0 = cosT; j.f1 = sinT; }
        else if (layer == 2) { j.B = W + W_NA_QK; j.N = 2048; j.epi = EPI_PLAIN2; }
        else { j.B = W + W_DIFF_QK; j.N = 2048; j.epi = EPI_ROPE; j.i0 = 16; j.f0 = cosT; j.f1 = sinT; }
        nj = 2;
        if (jidx == 0) return j;
        GemmJob v; v.o1 = nullptr; v.o2 = nullptr; v.f0 = v.f1 = nullptr; v.i0 = 0; v.s0 = 0.f; v.ksplit = 1; v.row0 = 0;
        v.A = W + (layer == 1 ? W_SWA_V : layer == 2 ? W_NA_V : W_DIFF_V); v.lda = 1024; v.B = H; v.ldb = 1024;
        v.M = layer == 1 ? 256 : 1024; v.N = MT; v.K = 1024; v.epi = EPI_VT; v.o0 = RVT;
        return v;
    }
    j.A = RD; j.lda = 1024; j.B = W + W_MLA_UQ; j.ldb = 512; j.M = MT; j.N = 1536; j.K = 512;
    j.epi = EPI_MLA_Q; j.o0 = RQ; j.o1 = (void*)cosT; j.f0 = stats; j.f1 = sinT;
    nj = 3;
    if (jidx == 0) return j;
    GemmJob k = j; k.A = RD + 512; k.B = W + W_MLA_UK; k.ldb = 256; k.N = 1024; k.K = 256; k.epi = EPI_MLA_K; k.o0 = RK; k.o1 = nullptr; k.f1 = nullptr;
    if (jidx == 1) return k;
    GemmJob v = k; v.A = W + W_MLA_UV; v.lda = 256; v.B = RD + 512; v.ldb = 1024; v.M = 1024; v.N = MT; v.epi = EPI_VT; v.o0 = RVT; v.i0 = 1;
    return v;
}

DI void run_phase(const Params& p, int ph, char* lds, const int wave_s, const bool dry = false) {
    char* ws = p.ws;
    float* X = (float*)(ws + OFF_X);
    bf16_t* H = (bf16_t*)(ws + OFF_H);
#ifndef NO_PREP
    if (ph == 0) { prep_phase(p, lds, fresh_tid(wave_s)); return; }
#endif
    if (ph == N_PHASES - 1) { final_phase(X, p.in[7], p.out, fresh_tid(wave_s)); return; }
    const int layer = (ph - 1) / 11, slot = (ph - 1) % 11;
    const float* mods_l = (const float*)(ws + OFF_MODS) + (size_t)layer * 5 * 9216;
    const bool last = layer == 3;
    if (slot == 0 || slot == 3 || slot == 8) {
        const int sub = slot == 0 ? 0 : slot == 3 ? 1 : 2;
        const float* part = (sub == 2) ? (const float*)(ws + OFF_R + R_DRAW) : (const float*)(ws + OFF_R + R_VT);
        const int npart = (sub == 2) ? 4 : ((sub == 0 && layer == 0) ? 0 : 11);
        norm_phase(X, p.in[6] + (size_t)(layer * 3 + sub) * 1024, mods_l, sub * 3, sub * 3 + 1, H, (last && sub == 2) ? NLAT : MT, fresh_tid(wave_s), part, (last && sub == 2) ? 0 : npart);
        return;
    }
#ifndef NO_ATTN
    if (slot == 6) {
        const int tid = fresh_tid(wave_s);
        AttnArgs a;
        a.q = (const bf16_t*)(ws + OFF_R + R_Q); a.k = (const bf16_t*)(ws + OFF_R + R_K); a.vt = (const bf16_t*)(ws + OFF_R + R_VT);
        a.ao = H; a.sink = nullptr; a.rpb = nullptr; a.lamp = nullptr; a.ng = nullptr; a.lam_init = 0.f; a.ctx_units = last ? 0 : 1;
        if (layer == 0) {
            a.q_ts = 2048; a.q_hs = 256; a.q_rot = 128; a.q_plain = 192; a.k_ts = 1536; a.k_hs = 192; a.NH = 8; a.scale = 0.07216878364870322f;
            attn_phase<192, 128, 0, false>(a, lds, tid);
        } else if (layer == 1) {
            a.q_ts = 2048; a.q_hs = 128; a.q_rot = 0; a.q_plain = 64; a.k_ts = 256; a.k_hs = 64; a.NH = 16; a.scale = 0.125f; a.sink = p.in[17];
            attn_phase<64, 64, 1, false>(a, lds, tid);
        } else if (layer == 2) {
            a.q_ts = 1024; a.q_hs = 64; a.q_rot = 0; a.q_plain = 0; a.k_ts = 1024; a.k_hs = 64; a.NH = 16; a.scale = 0.125f; a.rpb = p.in[20];
            attn_phase<64, 64, 2, false>(a, lds, tid);
        } else {
            a.q_ts = 2048; a.q_hs = 128; a.q_rot = 0; a.q_plain = 64; a.k_ts = 1024; a.k_hs = 128; a.NH = 8; a.scale = 0.125f;
            a.lamp = p.in[23]; a.ng = p.in[24]; a.lam_init = 0.5560582f;
            attn_phase<64, 128, 0, true>(a, lds, tid);
        }
        return;
    }
#endif
#ifndef NO_GEMM
    int nj = 1, rot = 0;
#pragma unroll 1
    for (int j = 0; j < nj; ++j) {
        const GemmJob job = get_job(p, layer, slot, j, nj, dry);
        gemm_run(job, lds, wave_s, rot);
        rot = (rot + (job.M / BM) * (job.N / BM) * job.ksplit) % (int)gridDim.x;
    }
#endif
}

__global__ void __launch_bounds__(NTHREADS) mega_kernel(Params p, int ph_lo, int ph_hi) {
    extern __shared__ __attribute__((aligned(16))) char lds[];
    cg::grid_group grid = cg::this_grid();
    const int wave_s = __builtin_amdgcn_readfirstlane(threadIdx.x >> 6);
    if (ph_lo > ph_hi) grid.sync();
    XcdBarrier xb; xb.bar = (unsigned*)(p.ws + OFF_BAR); xb.x = xb_xcc_id(); xb.st = (volatile LAS unsigned*)&lds[131072];
    if (ph_hi - ph_lo > 1) {
        const bool t0 = fresh_tid(wave_s) == 0;
        if (t0) { xb.st[0] = 0u; xb.st[1] = 0u; }
        __syncthreads();
        if (t0) (void)xb_add(&xb.bar[XB_XCNT(xb.x)], 1u);
    }
#pragma unroll 1
    for (int ph = ph_lo; ph < ph_hi; ++ph) {
        if (phase_is_noop(ph)) continue;
        run_phase(p, ph, lds, wave_s);
        if (PROBE_DUP) {
            const int slot_ = (ph >= 1 && ph < N_PHASES - 1) ? (ph - 1) % 11 : -1;
            bool dup = false;
            if (PROBE_DUP == 1) dup = ph == 0;
            if (PROBE_DUP == 3) dup = slot_ == 6;
            if (PROBE_DUP >= 30 && PROBE_DUP < 34) dup = slot_ == 6 && (ph - 1) / 11 == PROBE_DUP - 30;
            if (PROBE_DUP == 4) dup = slot_ == 0 || slot_ == 3 || slot_ == 8;
            if (PROBE_DUP == 5) dup = slot_ == 1 || slot_ == 9;
            if (PROBE_DUP == 6) dup = slot_ == 4 || slot_ == 5;
            if (PROBE_DUP == 7) dup = slot_ == 2 || slot_ == 10;
            if (PROBE_DUP == 8) dup = slot_ == 7;
            if (PROBE_DUP == 2) xcd_barrier(xb, fresh_tid(wave_s) == 0);
            if (dup) { xcd_barrier(xb, fresh_tid(wave_s) == 0); run_phase(p, ph, lds, wave_s, PROBE_DUP >= 7); }
        }
        if (ph + 1 < ph_hi) xcd_barrier(xb, fresh_tid(wave_s) == 0);
    }
}

extern "C" void kernel_launch(void* const* d_in, const int* in_sizes, int n_in, void* d_out, int out_size, void* d_ws, size_t ws_size,
                              hipStream_t stream) {
    static int grid_blocks = 0;
    if (!grid_blocks) {
        (void)hipFuncSetAttribute((const void*)mega_kernel, hipFuncAttributeMaxDynamicSharedMemorySize, LDS_BYTES);
        int dev = 0, cus = 0, per_cu = 0;
        (void)hipGetDevice(&dev);
        (void)hipDeviceGetAttribute(&cus, hipDeviceAttributeMultiprocessorCount, dev);
        (void)hipOccupancyMaxActiveBlocksPerMultiprocessor(&per_cu, mega_kernel, NTHREADS, LDS_BYTES);
        if (per_cu < 1) per_cu = 1;
        if (per_cu > 1) per_cu = 1;
        grid_blocks = cus * per_cu;
        grid_blocks -= grid_blocks % 8;
        if (ws_size < WS_NEED) fprintf(stderr, "workspace too small: %zu < %zu\n", ws_size, (size_t)WS_NEED);
    }
    Params p{};
    for (int i = 0; i < 26; ++i) p.in[i] = (const float*)d_in[i];
    p.out = (float*)d_out; p.ws = (char*)d_ws;
#if MK_SINGLE
    (void)hipMemsetAsync((char*)d_ws + OFF_BAR, 0, 16384, stream);
    int lo = 0, hi = N_PHASES;
    void* args[] = {&p, &lo, &hi};
    hipError_t e = hipLaunchCooperativeKernel((const void*)mega_kernel, dim3(grid_blocks), dim3(NTHREADS), args, LDS_BYTES, stream);
    if (e != hipSuccess) fprintf(stderr, "cooperative launch failed: %s (grid %d)\n", hipGetErrorString(e), grid_blocks);
#else
    for (int ph = 0; ph < N_PHASES; ++ph) {
        if (phase_is_noop(ph)) continue;
        mega_kernel<<<dim3(grid_blocks), dim3(NTHREADS), LDS_BYTES, stream>>>(p, ph, ph + 1);
    }
#endif
}
```

```cpp
#include <hip/hip_runtime.h>
#include <hip/hip_cooperative_groups.h>
#include <cstdio>
#include <cstdint>
namespace cg = cooperative_groups;

#ifndef MK_SINGLE
#define MK_SINGLE 1
#endif
#define PROBE_DUP 0

typedef unsigned short bf16_t;
typedef short bf16x8 __attribute__((ext_vector_type(8)));
typedef short s16x4 __attribute__((ext_vector_type(4)));
typedef float f32x4 __attribute__((ext_vector_type(4)));
typedef float f32x2 __attribute__((ext_vector_type(2)));
typedef float f32x16 __attribute__((ext_vector_type(16)));
typedef unsigned u32x4 __attribute__((ext_vector_type(4)));
typedef unsigned u32x2 __attribute__((ext_vector_type(2)));
typedef __bf16 bf2_t __attribute__((ext_vector_type(2)));
#define DI __device__ __forceinline__

constexpr int MT = 17408;
constexpr int NLAT = 16384;
constexpr int DM = 1024;
constexpr int DFF = 2816;
constexpr int NTHREADS = 512;
constexpr int LDS_BYTES = 131072 + 16;
constexpr float EPSV = 1e-6f;
constexpr float LOG2E = 1.4426950408889634f;
constexpr float RESCALE_THR = 8.0f;

constexpr size_t al256(size_t x) { return (x + 255) & ~(size_t)255; }
constexpr size_t OFF_BAR = 0;
constexpr size_t OFF_MODS = 16384;
constexpr size_t OFF_COS = al256(OFF_MODS + (size_t)4 * 5 * 9216 * 4);
constexpr size_t OFF_SIN = al256(OFF_COS + (size_t)4096 * 32 * 4);
constexpr size_t OFF_STATS = al256(OFF_SIN + (size_t)4096 * 32 * 4);
constexpr size_t OFF_X = al256(OFF_STATS + (size_t)MT * 16 * 4);
constexpr size_t OFF_H = al256(OFF_X + (size_t)MT * 1024 * 4);
constexpr size_t OFF_W = al256(OFF_H + (size_t)MT * 1024 * 2);
constexpr size_t W_IN = 0;
constexpr size_t W_OUT = W_IN + (size_t)8 * 5632 * 1024;
constexpr size_t W_MLA_DOWN = W_OUT + (size_t)8 * 1024 * 2816;
constexpr size_t W_MLA_UQ = W_MLA_DOWN + (size_t)1024 * 1024;
constexpr size_t W_MLA_UK = W_MLA_UQ + (size_t)1536 * 512;
constexpr size_t W_MLA_UV = W_MLA_UK + (size_t)1024 * 256;
constexpr size_t W_MLA_WO = W_MLA_UV + (size_t)1024 * 256;
constexpr size_t W_SWA_QK = W_MLA_WO + (size_t)1024 * 1024;
constexpr size_t W_SWA_V = W_SWA_QK + (size_t)1280 * 1024;
constexpr size_t W_SWA_WO = W_SWA_V + (size_t)256 * 1024;
constexpr size_t W_NA_QK = W_SWA_WO + (size_t)1024 * 1024;
constexpr size_t W_NA_V = W_NA_QK + (size_t)2048 * 1024;
constexpr size_t W_NA_WO = W_NA_V + (size_t)1024 * 1024;
constexpr size_t W_DIFF_QK = W_NA_WO + (size_t)1024 * 1024;
constexpr size_t W_DIFF_V = W_DIFF_QK + (size_t)2048 * 1024;
constexpr size_t W_DIFF_WO = W_DIFF_V + (size_t)1024 * 1024;
constexpr size_t W_TOTAL = W_DIFF_WO + (size_t)1024 * 1024;
constexpr size_t OFF_R = al256(OFF_W + W_TOTAL * 2);
constexpr size_t R_Q = 0;
constexpr size_t R_K = al256(R_Q + (size_t)MT * 2048 * 2);
constexpr size_t R_VT = al256(R_K + (size_t)MT * 1536 * 2);
constexpr size_t R_DRAW = al256(R_VT + (size_t)1024 * MT * 2);
constexpr size_t R_END = al256(R_DRAW + (size_t)MT * 1024 * 2);
constexpr size_t WS_NEED = OFF_R + R_END;

struct Params {
    const float* in[26];
    float* out;
    char* ws;
};

DI unsigned pack2(float lo, float hi) {
    f32x2 v = {lo, hi};
    bf2_t b = __builtin_convertvector(v, bf2_t);
    return __builtin_bit_cast(unsigned, b);
}
DI u32x2 pack4(f32x4 v) { u32x2 r; r.x = pack2(v[0], v[1]); r.y = pack2(v[2], v[3]); return r; }
DI float fexp2(float x) { return __builtin_amdgcn_exp2f(x); }
DI float siluf(float g) { return g * __builtin_amdgcn_rcpf(1.0f + __builtin_amdgcn_exp2f(-g * LOG2E)); }
DI int mod_row(int row) { return row < NLAT ? (row >> 12) : 4; }
template <int M> DI float swz_xor(float x) { return __int_as_float(__builtin_amdgcn_ds_swizzle(__float_as_int(x), (M << 10) | 0x1f)); }
DI float max_x32(float x) {
    auto r = __builtin_amdgcn_permlane32_swap(__float_as_uint(x), __float_as_uint(x), false, false);
    return fmaxf(__uint_as_float(r[0]), __uint_as_float(r[1]));
}
DI float bperm(float x, int addr) { return __int_as_float(__builtin_amdgcn_ds_bpermute(addr, __float_as_int(x))); }
DI float wave_sum(float x, int lane) {
    x += bperm(x, (lane ^ 32) << 2);
    x += swz_xor<16>(x); x += swz_xor<8>(x); x += swz_xor<4>(x); x += swz_xor<2>(x); x += swz_xor<1>(x);
    return x;
}
DI int fresh_tid(int wave_s) {
    int lane;
    asm volatile("v_mbcnt_lo_u32_b32 %0, -1, 0\n\tv_mbcnt_hi_u32_b32 %0, -1, %0" : "=v"(lane));
    return wave_s * 64 + lane;
}


#define XB_TMO      128
#define XB_XCNT(j)  (256  + 64 * (j))
#define XB_XSUB(j)  (1280 + 64 * (j))
#define XB_XGEN(j)  (2304 + 64 * (j))
#define XB_TOP      3328
#define XB_TOPGEN   3392
#define XCD_BAR_WORDS 3456
#define XB_SPIN_CAP (1u << 18)
#define LAS __attribute__((address_space(3)))
DI unsigned xb_ld(unsigned* p) { return __hip_atomic_load(p, __ATOMIC_RELAXED, __HIP_MEMORY_SCOPE_AGENT); }
DI unsigned xb_add(unsigned* p, unsigned v) { return __hip_atomic_fetch_add(p, v, __ATOMIC_RELAXED, __HIP_MEMORY_SCOPE_AGENT); }
DI unsigned xb_xcc_id() { return (unsigned)__builtin_amdgcn_s_getreg((3 << 11) | 20) & 0xFu; }
#define XB_SPIN(cond, bar) do { unsigned _sp = 0; while (cond) { __builtin_amdgcn_s_sleep(1); \
    if ((++_sp & 255u) == 0u) { if (xb_ld(&(bar)[XB_TMO])) break; if (_sp > XB_SPIN_CAP) { atomicAdd(&(bar)[XB_TMO], 1u); break; } } } } while (0)
struct XcdBarrier { unsigned* bar; unsigned x; volatile LAS unsigned* st; };
DI void xcd_barrier_complete(unsigned* bar, unsigned x, unsigned& nloc, unsigned& nx) {
    const unsigned G = gridDim.x * gridDim.y * gridDim.z;
    unsigned sum, cnt, mine, sp = 0u;
    for (;;) {
        sum = 0u; cnt = 0u; mine = 0u;
#pragma unroll
        for (unsigned j = 0; j < 16; ++j) { const unsigned c = xb_ld(&bar[XB_XCNT(j)]); sum += c; cnt += (c > 0u) ? 1u : 0u; mine = (j == x) ? c : mine; }
        if (sum == G) break;
        __builtin_amdgcn_s_sleep(1);
        if ((++sp & 255u) == 0u) { if (xb_ld(&bar[XB_TMO])) break; if (sp > XB_SPIN_CAP) { atomicAdd(&bar[XB_TMO], 1u); break; } }
    }
    nloc = mine > 0u ? mine : 1u; nx = cnt > 0u ? cnt : 1u;
}
DI void xcd_barrier(const XcdBarrier& b, const bool leader_thread) {
    asm volatile("s_waitcnt vmcnt(0)" ::: "memory");
    __syncthreads();
    if (leader_thread) {
        unsigned* bar = b.bar;
        __builtin_amdgcn_s_waitcnt(0);
        unsigned nloc = b.st[0], nx = b.st[1];
        if (nloc == 0u) { xcd_barrier_complete(bar, b.x, nloc, nx); b.st[0] = nloc; b.st[1] = nx; }
        const unsigned old = xb_add(&bar[XB_XSUB(b.x)], 1u);
        const unsigned gen = old / nloc;
        if (old + 1u == (gen + 1u) * nloc) {
            __builtin_amdgcn_fence(__ATOMIC_RELEASE, "agent");
            asm volatile("s_waitcnt vmcnt(0)" ::: "memory");
            const unsigned og = xb_add(&bar[XB_TOP], 1u);
            const unsigned tg = og / nx;
            if (og + 1u == (tg + 1u) * nx) xb_add(&bar[XB_TOPGEN], 1u);
            else XB_SPIN(xb_ld(&bar[XB_TOPGEN]) == tg, bar);
            __builtin_amdgcn_fence(__ATOMIC_ACQUIRE, "agent");
            xb_add(&bar[XB_XGEN(b.x)], 1u);
            asm volatile("s_waitcnt vmcnt(0)" ::: "memory");
        } else {
            XB_SPIN(xb_ld(&bar[XB_XGEN(b.x)]) == gen, bar);
            __builtin_amdgcn_fence(__ATOMIC_ACQUIRE, "agent");
            asm volatile("s_waitcnt vmcnt(0)" ::: "memory");
        }
    }
    __syncthreads();
}

constexpr int BM = 256, BK = 64, HALF = 128, HT = HALF * BK;
DI int lds_byte(int r, int c) {
    int st = (r >> 4) * 2 + (c >> 5), rr = r & 15, cc = c & 31, ob = rr * 64 + cc * 2;
    return st * 1024 + (ob ^ (((ob >> 9) & 1) << 5));
}
DI void stage_rc(int b, int& R, int& C) {
    int st = b / 1024, sb = b % 1024, swz = sb ^ (((sb >> 9) & 1) << 5);
    R = (st >> 1) * 16 + swz / 64; C = (st & 1) * 32 + (swz % 64) / 2;
}

enum { EPI_RESID = 0, EPI_RESID_ATOMIC, EPI_SWIGLU, EPI_PLAIN2, EPI_ROPE, EPI_MLA_DOWN, EPI_MLA_Q, EPI_MLA_K, EPI_VT };

struct GemmJob {
    const bf16_t* A; const bf16_t* B; int lda, ldb, M, N, K, epi;
    void* o0; void* o1; float* o2; const float* f0; const float* f1; int i0; float s0; int ksplit, row0;
};

DI void gemm_epilogue(const GemmJob& J, f32x4 (&acc)[2][2][4][2], int brow, int bcol, int wr, int wc, int fr, int fq, int ks) {
    const int epi = J.epi;
    if (epi == EPI_RESID) {
        const float* gp = J.f0 + (size_t)mod_row(brow) * 9216;
        const float cf = J.s0;
        f32x4 gv[2][2];
#pragma unroll
        for (int bj = 0; bj < 2; ++bj)
#pragma unroll
            for (int n = 0; n < 2; ++n) gv[bj][n] = *(const f32x4*)(gp + bcol + bj * HALF + wc * 32 + n * 16 + fq * 4) * cf;
#pragma unroll
        for (int ai = 0; ai < 2; ++ai) {
            f32x4 xv[4][2][2];
#pragma unroll
            for (int m = 0; m < 4; ++m) {
                const float* xp = (const float*)J.o0 + (size_t)(brow + ai * HALF + wr * 64 + m * 16 + fr) * DM + bcol + wc * 32 + fq * 4;
#pragma unroll
                for (int bj = 0; bj < 2; ++bj)
#pragma unroll
                    for (int n = 0; n < 2; ++n) xv[m][bj][n] = *(const f32x4*)(xp + bj * HALF + n * 16);
            }
            __builtin_amdgcn_sched_barrier(0);
#pragma unroll
            for (int m = 0; m < 4; ++m) {
                float* xp = (float*)J.o0 + (size_t)(brow + ai * HALF + wr * 64 + m * 16 + fr) * DM + bcol + wc * 32 + fq * 4;
#pragma unroll
                for (int bj = 0; bj < 2; ++bj)
#pragma unroll
                    for (int n = 0; n < 2; ++n) *(f32x4*)(xp + bj * HALF + n * 16) = xv[m][bj][n] + gv[bj][n] * acc[ai][bj][m][n];
            }
            __builtin_amdgcn_sched_barrier(0);
        }
        return;
    }
#pragma unroll
    for (int ai = 0; ai < 2; ++ai)
#pragma unroll
        for (int m = 0; m < 4; ++m) {
            const int row = brow + ai * HALF + wr * 64 + m * 16 + fr;
            if (epi == EPI_RESID) {
                const float* gp = J.f0 + (size_t)mod_row(row) * 9216;
                float* xp = (float*)J.o0 + (size_t)row * DM;
                const float cf = J.s0;
#pragma unroll
                for (int bj = 0; bj < 2; ++bj)
#pragma unroll
                    for (int n = 0; n < 2; ++n) {
                        const int col = bcol + bj * HALF + wc * 32 + n * 16 + fq * 4;
                        f32x4 g = *(const f32x4*)(gp + col);
                        f32x4 x = *(const f32x4*)(xp + col);
                        x += (g * cf) * acc[ai][bj][m][n];
                        *(f32x4*)(xp + col) = x;
                    }
            } else if (epi == EPI_RESID_ATOMIC) {
                const float* gp = J.f0 + (size_t)mod_row(row) * 9216;
                float* pp = J.o2 + ((size_t)ks * (MT - NLAT) + (row - NLAT)) * DM;
                const float cf = J.s0;
#pragma unroll
                for (int bj = 0; bj < 2; ++bj)
#pragma unroll
                    for (int n = 0; n < 2; ++n) {
                        const int col = bcol + bj * HALF + wc * 32 + n * 16 + fq * 4;
                        f32x4 g = *(const f32x4*)(gp + col);
                        *(f32x4*)(pp + col) = (g * cf) * acc[ai][bj][m][n];
                    }
            } else if (epi == EPI_SWIGLU) {
                bf16_t* op = (bf16_t*)J.o0 + (size_t)row * DFF + (bcol >> 1) + wc * 32 + fq * 8;
                f32x4 o0, o1;
#pragma unroll
                for (int j = 0; j < 4; ++j) { o0[j] = siluf(acc[ai][0][m][0][j]) * acc[ai][1][m][0][j]; o1[j] = siluf(acc[ai][0][m][1][j]) * acc[ai][1][m][1][j]; }
                u32x4 w; { const u32x2 a = pack4(o0), b = pack4(o1); w.x = a.x; w.y = a.y; w.z = b.x; w.w = b.y; }
                *(u32x4*)op = w;
            } else if (epi == EPI_PLAIN2) {
                bf16_t* q = (bf16_t*)J.o0 + (size_t)row * 1024;
                bf16_t* k = (bf16_t*)J.o1 + (size_t)row * 1024;
#pragma unroll
                for (int bj = 0; bj < 2; ++bj)
#pragma unroll
                    for (int n = 0; n < 2; ++n) {
                        const int col = bcol + bj * HALF + wc * 32 + n * 16 + fq * 4;
                        bf16_t* d = col < 1024 ? q + col : k + (col - 1024);
                        *(u32x2*)d = pack4(acc[ai][bj][m][n]);
                    }
            } else if (epi == EPI_ROPE) {
                const int NQH = J.i0, NKH = (J.N >> 6) - NQH;
                const bool latent = row < NLAT;
                const int pos = row & 4095;
#pragma unroll
                for (int bj = 0; bj < 2; ++bj) {
                    const int gcol = bcol + bj * HALF + wc * 32;
                    const int head64 = gcol >> 6, di = ((gcol >> 5) & 1) * 16 + fq * 4;
                    f32x4 v0 = acc[ai][bj][m][0], v1 = acc[ai][bj][m][1], r1 = v0, r2 = v1;
                    if (latent) {
                        f32x4 c4 = *(const f32x4*)(J.f0 + pos * 32 + di), s4 = *(const f32x4*)(J.f1 + pos * 32 + di);
                        r1 = v0 * c4 - v1 * s4; r2 = v0 * s4 + v1 * c4;
                    }
                    if (head64 < NQH) {
                        bf16_t* q = (bf16_t*)J.o0 + (size_t)row * (NQH * 128) + head64 * 128;
                        *(u32x2*)(q + 64 + di) = pack4(v0); *(u32x2*)(q + 96 + di) = pack4(v1);
                        *(u32x2*)(q + di) = pack4(r1); *(u32x2*)(q + 32 + di) = pack4(r2);
                    } else {
                        bf16_t* k = (bf16_t*)J.o1 + (size_t)row * (NKH * 64) + (head64 - NQH) * 64;
                        *(u32x2*)(k + di) = pack4(r1); *(u32x2*)(k + 32 + di) = pack4(r2);
                    }
                }
            } else if (epi == EPI_MLA_DOWN) {
                const int pn = bcol >> 8;
                if (pn < 3) {
                    bf16_t* d = (bf16_t*)J.o0 + (size_t)row * 1024;
                    float ss = 0.f;
#pragma unroll
                    for (int bj = 0; bj < 2; ++bj)
#pragma unroll
                        for (int n = 0; n < 2; ++n) {
                            const int col = bcol + bj * HALF + wc * 32 + n * 16 + fq * 4;
                            f32x4 v = acc[ai][bj][m][n];
                            ss += v[0] * v[0] + v[1] * v[1] + v[2] * v[2] + v[3] * v[3];
                            *(u32x2*)(d + col) = pack4(v);
                        }
                    ss += swz_xor<16>(ss); ss += bperm(ss, ((fq * 16 + fr) ^ 32) << 2);
                    if (fq == 0) J.o2[(size_t)row * 16 + pn * 4 + wc] = ss;
                } else if (wc < 2) {
                    const bool latent = row < NLAT;
                    const int pos = row & 4095, di = wc * 16 + fq * 4;
                    f32x4 v0 = acc[ai][0][m][0], v1 = acc[ai][0][m][1], r1 = v0, r2 = v1;
                    if (latent) {
                        f32x4 c4 = *(const f32x4*)(J.f0 + pos * 32 + di), s4 = *(const f32x4*)(J.f1 + pos * 32 + di);
                        r1 = v0 * c4 - v1 * s4; r2 = v0 * s4 + v1 * c4;
                    }
                    u32x2 p1 = pack4(r1), p2 = pack4(r2);
                    bf16_t* k = (bf16_t*)J.o1 + (size_t)row * 1536 + 128 + di;
#pragma unroll
                    for (int hh = 0; hh < 8; ++hh) { *(u32x2*)(k + hh * 192) = p1; *(u32x2*)(k + hh * 192 + 32) = p2; }
                }
            } else if (epi == EPI_MLA_Q) {
                const float* sp = J.f0 + (size_t)row * 16;
                f32x4 a = *(const f32x4*)sp, b = *(const f32x4*)(sp + 4);
                const float rstd = rsqrtf((a[0] + a[1] + a[2] + a[3] + b[0] + b[1] + b[2] + b[3]) * (1.0f / 512.0f) + EPSV);
                const bool latent = row < NLAT;
                const int pos = row & 4095;
                const float* cosT = (const float*)J.o1; const float* sinT = J.f1;
#pragma unroll
                for (int bj = 0; bj < 2; ++bj) {
                    const int g = (bcol + bj * HALF + wc * 32) >> 5;
                    const int head = g / 6, gi = g - head * 6;
                    bf16_t* q = (bf16_t*)J.o0 + (size_t)row * 2048 + head * 256;
                    f32x4 v0 = acc[ai][bj][m][0] * rstd, v1 = acc[ai][bj][m][1] * rstd;
                    if (gi < 4) {
                        *(u32x2*)(q + gi * 32 + fq * 4) = pack4(v0); *(u32x2*)(q + gi * 32 + 16 + fq * 4) = pack4(v1);
                    } else {
                        const int di = (gi - 4) * 16 + fq * 4;
                        *(u32x2*)(q + 192 + di) = pack4(v0); *(u32x2*)(q + 224 + di) = pack4(v1);
                        if (latent) {
                            f32x4 c4 = *(const f32x4*)(cosT + pos * 32 + di), s4 = *(const f32x4*)(sinT + pos * 32 + di);
                            *(u32x2*)(q + 128 + di) = pack4(v0 * c4 - v1 * s4); *(u32x2*)(q + 160 + di) = pack4(v0 * s4 + v1 * c4);
                        }
                    }
                }
            } else if (epi == EPI_MLA_K) {
                f32x4 a = *(const f32x4*)(J.f0 + (size_t)row * 16 + 8);
                const float rstd = rsqrtf((a[0] + a[1] + a[2] + a[3]) * (1.0f / 256.0f) + EPSV);
                bf16_t* k = (bf16_t*)J.o0 + (size_t)row * 1536;
#pragma unroll
                for (int bj = 0; bj < 2; ++bj)
#pragma unroll
                    for (int n = 0; n < 2; ++n) {
                        const int col = bcol + bj * HALF + wc * 32 + n * 16 + fq * 4;
                        *(u32x2*)(k + (col >> 7) * 192 + (col & 127)) = pack4(acc[ai][bj][m][n] * rstd);
                    }
            } else {
                bf16_t* vt = (bf16_t*)J.o0 + (size_t)row * MT;
#pragma unroll
                for (int bj = 0; bj < 2; ++bj)
#pragma unroll
                    for (int n = 0; n < 2; ++n) {
                        const int col = bcol + bj * HALF + wc * 32 + n * 16 + fq * 4;
                        f32x4 v = acc[ai][bj][m][n];
                        if (J.i0) {
#pragma unroll
                            for (int j = 0; j < 4; ++j) {
                                f32x4 a = *(const f32x4*)(J.f0 + (size_t)(col + j) * 16 + 8);
                                v[j] *= rsqrtf((a[0] + a[1] + a[2] + a[3]) * (1.0f / 256.0f) + EPSV);
                            }
                        }
                        *(u32x2*)(vt + col) = pack4(v);
                    }
            }
            __builtin_amdgcn_sched_barrier(0);
        }
}

DI void gemm_run(const GemmJob& J, char* lds, const int tid_in, const int rot) {
    bf16_t* shm = (bf16_t*)lds;
    const int lda = J.lda, ldb = J.ldb, ksplit = J.ksplit;
    const __amdgpu_buffer_rsrc_t rs_A = __builtin_amdgcn_make_buffer_rsrc((void*)J.A, 0, 0x7fffffff, 0x00020000);
    const __amdgpu_buffer_rsrc_t rs_Bt = __builtin_amdgcn_make_buffer_rsrc((void*)J.B, 0, 0x7fffffff, 0x00020000);
#define SA(b, h) (shm + ((b) * 2 + (h)) * HT)
#define SB(b, h) (shm + (4 + (b) * 2 + (h)) * HT)
#define STAGE(P, BASE, OFF, LD, br, kt) do { const int _so = ((br) * (LD) + (kt) * BK) * 2 + kbyte; \
    for (int _i = 0; _i < 2; ++_i) { \
      __builtin_amdgcn_raw_ptr_buffer_load_lds(rs_##BASE, \
        (__attribute__((address_space(3))) unsigned*)((char*)(P) + tid_in * 1024 + _i * 8192), 16, OFF[_i], _so, 0, 0); } } while (0)
#define LDA(dst, b, h) for (int m = 0; m < 4; ++m) for (int k = 0; k < 2; ++k) \
    dst[m][k] = *reinterpret_cast<const bf16x8*>((char*)SA(b, h) + lds_byte(wr * 64 + m * 16 + fr, k * 32 + fq * 8))
#define LDB(dst, b, h) for (int n = 0; n < 2; ++n) for (int k = 0; k < 2; ++k) \
    dst[n][k] = *reinterpret_cast<const bf16x8*>((char*)SB(b, h) + lds_byte(wc * 32 + n * 16 + fr, k * 32 + fq * 8))
#define MMA(ai, bj, At_, Bt_) do { __builtin_amdgcn_s_setprio(1); \
    for (int m = 0; m < 4; ++m) for (int n = 0; n < 2; ++n) for (int k = 0; k < 2; ++k) \
      acc[ai][bj][m][n] = __builtin_amdgcn_mfma_f32_16x16x32_bf16(Bt_[n][k], At_[m][k], acc[ai][bj][m][n], 0, 0, 0); \
    __builtin_amdgcn_s_setprio(0); } while (0)
#define WAIT_V(n) asm volatile("s_waitcnt vmcnt(" #n ")" ::: "memory")
#define WAIT_L(n) asm volatile("s_waitcnt lgkmcnt(" #n ")" ::: "memory")
#define BAR __builtin_amdgcn_s_barrier()
#define SCHED __builtin_amdgcn_sched_barrier(0)
    const int nM = J.M / BM, nN = J.N / BM, nwg = nM * nN * J.ksplit;
    const int nt = J.K / J.ksplit / BK;
    for (int it = 0;; ++it) {
        int cshift = (int)blockIdx.x - rot; if (cshift < 0) cshift += gridDim.x;
        const long L = (long)it * gridDim.x + cshift;
        if (L >= nwg) break;
        const int tid = fresh_tid(tid_in);
        const int wid = tid >> 6, lane = tid & 63, wr = wid >> 2, wc = wid & 3, fr = lane & 15, fq = lane >> 4;
        unsigned offA[2], offB[2];
#pragma unroll
        for (int i = 0; i < 2; ++i) { int r_, c_; stage_rc(tid * 16 + i * 8192, r_, c_); offA[i] = (unsigned)(r_ * lda + c_) * 2u; offB[i] = (unsigned)(r_ * ldb + c_) * 2u; }
        int pm, pn, kbyte = 0, ksel = 0;
        if (ksplit > 1) {
            const int tile = (int)L / ksplit, ks = (int)L % ksplit; ksel = ks;
            pm = tile % nM; pn = tile / nM;
            kbyte = ks * (J.K / ksplit) * 2;
        } else {
            int wgid = (int)L;
            { const int q = nwg / 8, r = nwg % 8, xcd = wgid % 8, off = wgid / 8; wgid = (xcd < r ? xcd * (q + 1) : r * (q + 1) + (xcd - r) * q) + off; }
            const int nig = 8 * nN, gid = wgid / nig, fm = gid * 8, gsz = (nM - fm) < 8 ? (nM - fm) : 8;
            pm = fm + ((wgid % nig) % gsz); pn = (wgid % nig) / gsz;
        }
        const int brow = pm * BM, bcol = pn * BM;
        f32x4 acc[2][2][4][2];
#pragma unroll
        for (int a = 0; a < 2; ++a)
#pragma unroll
            for (int b = 0; b < 2; ++b)
#pragma unroll
                for (int m = 0; m < 4; ++m)
#pragma unroll
                    for (int n = 0; n < 2; ++n) acc[a][b][m][n] = (f32x4){0.f, 0.f, 0.f, 0.f};
        bf16x8 At[4][2], B0[2][2], B1[2][2];
        WAIT_V(0);
        STAGE(SB(0, 0), Bt, offB, ldb, bcol, 0); STAGE(SA(0, 0), A, offA, lda, brow, 0);
        STAGE(SB(0, 1), Bt, offB, ldb, bcol + HALF, 0); STAGE(SA(0, 1), A, offA, lda, brow + HALF, 0);
        if (wr == 1) BAR;
        WAIT_V(4); BAR;
        STAGE(SB(1, 0), Bt, offB, ldb, bcol, 1); STAGE(SA(1, 0), A, offA, lda, brow, 1); STAGE(SB(1, 1), Bt, offB, ldb, bcol + HALF, 1);
        WAIT_V(6); BAR;
        for (int t = 0; t < nt - 2; t += 2) {
            LDB(B0, 0, 0); SCHED; LDA(At, 0, 0); STAGE(SA(1, 1), A, offA, lda, brow + HALF, t + 1);
            WAIT_L(8); BAR; WAIT_L(0); MMA(0, 0, At, B0); BAR; SCHED;
            LDB(B1, 0, 1); STAGE(SB(0, 0), Bt, offB, ldb, bcol, t + 2);
            BAR; WAIT_L(0); MMA(0, 1, At, B1); BAR;
            LDA(At, 0, 1); STAGE(SA(0, 0), A, offA, lda, brow, t + 2);
            BAR; WAIT_L(0); MMA(1, 0, At, B0); BAR; SCHED;
            STAGE(SB(0, 1), Bt, offB, ldb, bcol + HALF, t + 2);
            WAIT_V(6); BAR; MMA(1, 1, At, B1); BAR;
            LDB(B0, 1, 0); SCHED; LDA(At, 1, 0); STAGE(SA(0, 1), A, offA, lda, brow + HALF, t + 2);
            WAIT_L(8); BAR; WAIT_L(0); MMA(0, 0, At, B0); BAR; SCHED;
            LDB(B1, 1, 1); STAGE(SB(1, 0), Bt, offB, ldb, bcol, t + 3);
            BAR; WAIT_L(0); MMA(0, 1, At, B1); BAR;
            LDA(At, 1, 1); STAGE(SA(1, 0), A, offA, lda, brow, t + 3);
            BAR; WAIT_L(0); MMA(1, 0, At, B0); BAR; SCHED;
            STAGE(SB(1, 1), Bt, offB, ldb, bcol + HALF, t + 3);
            WAIT_V(6); BAR; MMA(1, 1, At, B1); BAR;
        }
        { LDB(B0, 0, 0); LDA(At, 0, 0); STAGE(SA(1, 1), A, offA, lda, brow + HALF, nt - 1);
          BAR; WAIT_L(0); MMA(0, 0, At, B0); BAR;
          LDB(B1, 0, 1); BAR; WAIT_L(0); MMA(0, 1, At, B1); BAR;
          LDA(At, 0, 1); WAIT_V(4); BAR; WAIT_L(0); MMA(1, 0, At, B0); MMA(1, 1, At, B1); BAR; }
        { LDB(B0, 1, 0); LDA(At, 1, 0); WAIT_V(2); BAR; WAIT_L(0); MMA(0, 0, At, B0); BAR;
          LDB(B1, 1, 1); WAIT_V(0); BAR; WAIT_L(0); MMA(0, 1, At, B1); BAR;
          LDA(At, 1, 1); BAR; WAIT_L(0); MMA(1, 0, At, B0); MMA(1, 1, At, B1); BAR; }
        if (wr == 0) BAR;
        { const int tid2 = fresh_tid(tid_in);
          const int wid2 = tid2 >> 6, lane2 = tid2 & 63;
          gemm_epilogue(J, acc, brow + J.row0, bcol, wid2 >> 2, wid2 & 3, lane2 & 15, lane2 >> 4, ksel); }
    }
#undef SA
#undef SB
}

struct AttnArgs {
    const bf16_t* q; int q_ts, q_hs, q_rot, q_plain;
    const bf16_t* k; int k_ts, k_hs;
    const bf16_t* vt; bf16_t* ao;
    int NH; int ctx_units; float scale;
    const float* sink; const float* rpb; const float* lamp; const float* ng; float lam_init;
};

DI int crow(int i, int h) { return (i & 3) + 8 * (i >> 2) + 4 * h; }

template <int DQK, int DV, int MODE, bool PAIR>
DI void attn_phase(const AttnArgs& a, char* lds, const int tid) {
    constexpr int KW = PAIR ? 128 : DQK;
    constexpr int KST = KW * 2 + 16;
    constexpr int VST = 136;
    constexpr int KBYTES = 64 * KST, VBYTES = DV * VST, BUF = KBYTES + VBYTES;
    constexpr int QB = PAIR ? 128 : 256;
    constexpr int NQB = 4096 / QB;
    constexpr int NS = DQK / 16, NDB = DV / 32;
    constexpr int KCH = (64 * KW * 2 / 16) / NTHREADS;
    constexpr int VCH = (DV * 128 / 16) / NTHREADS;
    constexpr int NOPE = DQK - 64;
    static_assert(2 * BUF <= 120 * 1024, "lds");
    const int wave = tid >> 6, lane = tid & 63, r = lane & 31, h = lane >> 5;
    const int x32 = (lane ^ 32) << 2;
    const int wq = PAIR ? (wave & 3) : wave, gsel = PAIR ? (wave >> 2) : 0;
    const int koff = gsel * 64;
    const float cs = a.scale * LOG2E;
    float* rpbL = (float*)(lds + 122880);
    const int n_lat = 4 * a.NH * NQB;
    const int n_units = n_lat + (a.ctx_units ? 4 * a.NH : 0);
    float lam = 0.f;
    if (PAIR) {
        float p0 = a.lamp[lane] * a.lamp[64 + lane], p1 = a.lamp[128 + lane] * a.lamp[192 + lane];
        p0 = wave_sum(p0, lane); p1 = wave_sum(p1, lane);
        lam = __expf(p0) - __expf(p1) + a.lam_init;
    }
    for (int u = blockIdx.x; u < n_units; u += gridDim.x) {
        const bool isctx = u >= n_lat;
        int b, hh, qb;
        if (!isctx) { qb = u % NQB; hh = (u / NQB) % a.NH; b = u / (NQB * a.NH); }
        else { const int v = u - n_lat; qb = 0; hh = v % a.NH; b = v / a.NH; }
        const int tokq0 = isctx ? (NLAT + b * 256) : (b * 4096 + qb * QB);
        const int tokq = tokq0 + wq * 32 + r;
        const int qhead = PAIR ? 2 * hh + gsel : hh;
        const int kvhead = (MODE == 1) ? (hh >> 2) : hh;
        const bf16_t* qp = a.q + (size_t)tokq * a.q_ts + qhead * a.q_hs;
        const bf16_t* kbase = a.k + kvhead * a.k_hs;
        const bf16_t* vbase = a.vt + (size_t)(kvhead * DV) * MT;
        int tlo = 0, thi = 0;
        if (!isctx) {
            if (MODE == 0) { tlo = 0; thi = 64; }
            else if (MODE == 1) { const int q0 = qb * QB; tlo = (q0 - 128) < 0 ? 0 : (q0 - 128) >> 6; thi = (q0 + QB + 128) >> 6; if (thi > 64) thi = 64; }
            else { const int r0 = qb * 4; int lo = r0 - 4; lo = lo < 0 ? 0 : (lo > 56 ? 56 : lo); int hi2 = r0 + 3 - 4; hi2 = hi2 < 0 ? 0 : (hi2 > 56 ? 56 : hi2); tlo = lo; thi = hi2 + 8; }
        }
        const int T = 4 + (thi - tlo);
        if (MODE == 2) {
            for (int i = tid; i < 465; i += NTHREADS) rpbL[i] = a.rpb[hh * 465 + i];
        }
        const int qpos = qb * QB + wq * 32 + r;
        const int qrow = qpos >> 6, qcol = qpos & 63;
        int cstart = qcol - 8; cstart = cstart < 0 ? 0 : (cstart > 48 ? 48 : cstart);
        int rstart = qrow - 4; rstart = rstart < 0 ? 0 : (rstart > 56 ? 56 : rstart);

        constexpr bool D2 = (KCH + VCH) <= 4;
        constexpr int NSET = D2 ? 2 : 1;
        u32x4 kreg[NSET][KCH], vreg[NSET][VCH];
        const __amdgpu_buffer_rsrc_t rs_k = __builtin_amdgcn_make_buffer_rsrc((void*)kbase, 0, 0x7fffffff, 0x00020000);
        const __amdgpu_buffer_rsrc_t rs_v = __builtin_amdgcn_make_buffer_rsrc((void*)vbase, 0, 0x7fffffff, 0x00020000);
        auto tile_tok = [&](int t) { return t < 4 ? (NLAT + b * 256 + t * 64) : (b * 4096 + (tlo + t - 4) * 64); };
        auto load_tile = [&](int t, const int set) __attribute__((always_inline)) {
            const int tok = tile_tok(t);
#pragma unroll
            for (int c = 0; c < KCH; ++c) { const int idx = tid + c * NTHREADS, row = idx / (KW / 8), ch = idx % (KW / 8);
                kreg[set][c] = __builtin_amdgcn_raw_buffer_load_b128(rs_k, (row * a.k_ts + ch * 8) * 2, tok * a.k_ts * 2, 0); }
#pragma unroll
            for (int c = 0; c < VCH; ++c) { const int idx = tid + c * NTHREADS, row = idx >> 3, ch = idx & 7;
                vreg[set][c] = __builtin_amdgcn_raw_buffer_load_b128(rs_v, (row * MT + ch * 8) * 2, tok * 2, 0); }
        };
        auto store_tile = [&](int buf, const int set) __attribute__((always_inline)) {
            char* kb = lds + buf * BUF; char* vb = kb + KBYTES;
#pragma unroll
            for (int c = 0; c < KCH; ++c) { const int idx = tid + c * NTHREADS, row = idx / (KW / 8), ch = idx % (KW / 8);
                *(u32x4*)(kb + row * KST + ch * 16) = kreg[set][c]; }
#pragma unroll
            for (int c = 0; c < VCH; ++c) { const int idx = tid + c * NTHREADS, row = idx >> 3, ch = idx & 7;
                u32x2 w0 = {vreg[set][c].x, vreg[set][c].y}, w1 = {vreg[set][c].z, vreg[set][c].w};
                *(u32x2*)(vb + row * VST + ch * 16) = w0; *(u32x2*)(vb + row * VST + ch * 16 + 8) = w1; }
        };
        bf16x8 qf[NS];
        auto load_q = [&](bool lat) {
#pragma unroll
            for (int s = 0; s < NS; ++s) {
                const int off = (s * 16 < NOPE) ? s * 16 : ((lat ? a.q_rot : a.q_plain) + s * 16 - NOPE);
                qf[s] = *(const bf16x8*)(qp + off + 8 * h);
            }
        };
        f32x16 ot[NDB];
#pragma unroll
        for (int d = 0; d < NDB; ++d)
#pragma unroll
            for (int i = 0; i < 16; ++i) ot[d][i] = 0.f;
        float m_run = -1e30f, l_run = 0.f;

        load_tile(0, 0); store_tile(0, 0);
        if (D2) load_tile(T > 1 ? 1 : 0, 1);
        load_q(false);
        __syncthreads();
        auto tile_body = [&](const int t, const bool LAT, const int PAR) __attribute__((always_inline)) {
            if (D2) load_tile(t + 2 < T ? t + 2 : T - 1, PAR);
            else load_tile(t + 1 < T ? t + 1 : T - 1, 0);
            const char* kb_l = lds + (t & 1) * BUF; const char* vb_l = kb_l + KBYTES;
            bool skip = false;
            const int kt = tlo + t - 4;
            if (LAT) {
                if (MODE == 1) { const int ts = kt * 64, qw = qb * QB + wq * 32; skip = (ts + 63 < qw - 128) || (ts > qw + 31 + 128); }
                if (MODE == 2) { skip = (kt < rstart) || (kt >= rstart + 8); }
            }
            if (!skip) {
              if constexpr (DQK == 64) {
                constexpr int G = (NS <= 4) ? NS : 6;
                constexpr bool VBOTH = (DV == 64);
                f32x16 st[2];
#pragma unroll
                for (int i = 0; i < 16; ++i) { st[0][i] = 0.f; st[1][i] = 0.f; }
#pragma unroll
                for (int g0 = 0; g0 < NS; g0 += G) {
                    bf16x8 ka[G], kc[G];
#pragma unroll
                    for (int s = 0; s < G; ++s) {
                        ka[s] = *(const bf16x8*)(kb_l + r * KST + (koff + 8 * h) * 2 + (g0 + s) * 32);
                        kc[s] = *(const bf16x8*)(kb_l + (32 + r) * KST + (koff + 8 * h) * 2 + (g0 + s) * 32);
                    }
                    __builtin_amdgcn_sched_barrier(0);
#pragma unroll
                    for (int s = 0; s < G; ++s) {
                        st[0] = __builtin_amdgcn_mfma_f32_32x32x16_bf16(ka[s], qf[g0 + s], st[0], 0, 0, 0);
                        st[1] = __builtin_amdgcn_mfma_f32_32x32x16_bf16(kc[s], qf[g0 + s], st[1], 0, 0, 0);
                    }
                }
                s16x4 vlo[VBOTH ? 2 : 1][2][NDB], vhi[VBOTH ? 2 : 1][2][NDB];
#pragma unroll
                for (int kb = 0; kb < (VBOTH ? 2 : 1); ++kb)
#pragma unroll
                    for (int s2 = 0; s2 < 2; ++s2)
#pragma unroll
                        for (int d = 0; d < NDB; ++d) {
                            const char* vp = vb_l + (32 * d + r) * VST + (32 * kb + 16 * s2 + 4 * h) * 2;
                            vlo[kb][s2][d] = *(const s16x4*)vp; vhi[kb][s2][d] = *(const s16x4*)(vp + 16);
                        }
                __builtin_amdgcn_sched_barrier(0);
                const bool MASKED = (MODE != 0) && LAT;
                float mx = -3e38f;
                if (MASKED) {
#pragma unroll
                    for (int kb = 0; kb < 2; ++kb)
#pragma unroll
                        for (int i = 0; i < 16; ++i) {
                            float tv = st[kb][i] * cs;
                            if (MODE == 1) {
                                const int d = kt * 64 + 32 * kb + crow(i, h) - qpos; const bool valid = (d <= 128) && (d >= -128); tv = valid ? tv : -1e30f;
                            } else if (MODE == 2) {
                                const int kc2 = 32 * kb + crow(i, h);
                                const bool valid = (kc2 >= cstart) && (kc2 < cstart + 16);
                                int bi = (kt - qrow + 7) * 31 + (kc2 - qcol + 15); bi = valid ? bi : 0;
                                const float bias = rpbL[bi];
                                tv = valid ? (tv + bias * LOG2E) : -1e30f;
                            }
                            st[kb][i] = tv; mx = fmaxf(mx, tv);
                        }
                } else {
#pragma unroll
                    for (int kb = 0; kb < 2; ++kb)
#pragma unroll
                        for (int i = 0; i < 16; ++i) mx = fmaxf(mx, st[kb][i]);
                    mx *= cs;
                }
                mx = max_x32(mx);
                if (__any(mx - m_run > RESCALE_THR)) {
                    const float m_up = fmaxf(m_run, mx);
                    const float alpha = fexp2(m_run - m_up);
                    l_run *= alpha;
#pragma unroll
                    for (int d = 0; d < NDB; ++d)
#pragma unroll
                        for (int i = 0; i < 16; ++i) ot[d][i] *= alpha;
                    m_run = m_up;
                }
                const float m_new = m_run;
                float rs = 0.f;
#pragma unroll
                for (int kb = 0; kb < 2; ++kb)
#pragma unroll
                    for (int i = 0; i < 16; ++i) {
                        const float p = MASKED ? fexp2(st[kb][i] - m_new) : fexp2(__builtin_fmaf(st[kb][i], cs, -m_new));
                        st[kb][i] = p; rs += p;
                    }
                l_run += rs;
#pragma unroll
                for (int kb = 0; kb < 2; ++kb) {
                    if (!VBOTH && kb == 1) {
#pragma unroll
                        for (int s2 = 0; s2 < 2; ++s2)
#pragma unroll
                            for (int d = 0; d < NDB; ++d) {
                                const char* vp = vb_l + (32 * d + r) * VST + (32 + 16 * s2 + 4 * h) * 2;
                                vlo[0][s2][d] = *(const s16x4*)vp; vhi[0][s2][d] = *(const s16x4*)(vp + 16);
                            }
                    }
                    const int vs = VBOTH ? kb : 0;
#pragma unroll
                    for (int s2 = 0; s2 < 2; ++s2) {
                        u32x4 pw;
                        pw.x = pack2(st[kb][8 * s2 + 0], st[kb][8 * s2 + 1]); pw.y = pack2(st[kb][8 * s2 + 2], st[kb][8 * s2 + 3]);
                        pw.z = pack2(st[kb][8 * s2 + 4], st[kb][8 * s2 + 5]); pw.w = pack2(st[kb][8 * s2 + 6], st[kb][8 * s2 + 7]);
                        const bf16x8 pf = __builtin_bit_cast(bf16x8, pw);
#pragma unroll
                        for (int d = 0; d < NDB; ++d) {
                            const bf16x8 vf = __builtin_shufflevector(vlo[vs][s2][d], vhi[vs][s2][d], 0, 1, 2, 3, 4, 5, 6, 7);
                            ot[d] = __builtin_amdgcn_mfma_f32_32x32x16_bf16(vf, pf, ot[d], 0, 0, 0);
                        }
                    }
                }
              } else {
                constexpr bool PREK = NS <= 4;
                bf16x8 kf[NS];
#pragma unroll
                for (int s = 0; s < NS; ++s) kf[s] = *(const bf16x8*)(kb_l + r * KST + (koff + 8 * h) * 2 + s * 32);
#pragma unroll
                for (int kb = 0; kb < 2; ++kb) {
                    f32x16 st;
#pragma unroll
                    for (int i = 0; i < 16; ++i) st[i] = 0.f;
                    __builtin_amdgcn_sched_barrier(0);
#pragma unroll
                    for (int s = 0; s < NS; ++s) st = __builtin_amdgcn_mfma_f32_32x32x16_bf16(kf[s], qf[s], st, 0, 0, 0);
                    s16x4 vlo[2][NDB], vhi[2][NDB];
#pragma unroll
                    for (int s2 = 0; s2 < 2; ++s2)
#pragma unroll
                        for (int d = 0; d < NDB; ++d) {
                            const char* vp = vb_l + (32 * d + r) * VST + (32 * kb + 16 * s2 + 4 * h) * 2;
                            vlo[s2][d] = *(const s16x4*)vp; vhi[s2][d] = *(const s16x4*)(vp + 16);
                        }
                    if (kb == 0) {
                        if (PREK) {
#pragma unroll
                            for (int s = 0; s < NS; ++s) kf[s] = *(const bf16x8*)(kb_l + (32 + r) * KST + (koff + 8 * h) * 2 + s * 32);
                        }
                    }
                    __builtin_amdgcn_sched_barrier(0);
                    const bool MASKED = (MODE != 0) && LAT;
                    float mx = -3e38f;
                    if (MASKED) {
#pragma unroll
                        for (int i = 0; i < 16; ++i) {
                            float tv = st[i] * cs;
                            if (MODE == 1) {
                                const int d = kt * 64 + 32 * kb + crow(i, h) - qpos; const bool valid = (d <= 128) && (d >= -128); tv = valid ? tv : -1e30f;
                            } else if (MODE == 2) {
                                const int kc = 32 * kb + crow(i, h);
                                const bool valid = (kc >= cstart) && (kc < cstart + 16);
                                int bi = (kt - qrow + 7) * 31 + (kc - qcol + 15); bi = valid ? bi : 0;
                                const float bias = rpbL[bi];
                                tv = valid ? (tv + bias * LOG2E) : -1e30f;
                            }
                            st[i] = tv; mx = fmaxf(mx, tv);
                        }
                    } else {
#pragma unroll
                        for (int i = 0; i < 16; ++i) mx = fmaxf(mx, st[i]);
                        mx *= cs;
                    }
                    mx = max_x32(mx);
                    if (__any(mx - m_run > RESCALE_THR)) {
                        const float m_up = fmaxf(m_run, mx);
                        const float alpha = fexp2(m_run - m_up);
                        l_run *= alpha;
#pragma unroll
                        for (int d = 0; d < NDB; ++d)
#pragma unroll
                            for (int i = 0; i < 16; ++i) ot[d][i] *= alpha;
                        m_run = m_up;
                    }
                    const float m_new = m_run;
                    float rs = 0.f;
                    if (MASKED) {
#pragma unroll
                        for (int i = 0; i < 16; ++i) { const float p = fexp2(st[i] - m_new); st[i] = p; rs += p; }
                    } else {
#pragma unroll
                        for (int i = 0; i < 16; ++i) { const float p = fexp2(__builtin_fmaf(st[i], cs, -m_new)); st[i] = p; rs += p; }
                    }
                    l_run += rs;
#pragma unroll
                    for (int s2 = 0; s2 < 2; ++s2) {
                        u32x4 pw;
                        pw.x = pack2(st[8 * s2 + 0], st[8 * s2 + 1]); pw.y = pack2(st[8 * s2 + 2], st[8 * s2 + 3]);
                        pw.z = pack2(st[8 * s2 + 4], st[8 * s2 + 5]); pw.w = pack2(st[8 * s2 + 6], st[8 * s2 + 7]);
                        const bf16x8 pf = __builtin_bit_cast(bf16x8, pw);
#pragma unroll
                        for (int d = 0; d < NDB; ++d) {
                            const bf16x8 vf = __builtin_shufflevector(vlo[s2][d], vhi[s2][d], 0, 1, 2, 3, 4, 5, 6, 7);
                            ot[d] = __builtin_amdgcn_mfma_f32_32x32x16_bf16(vf, pf, ot[d], 0, 0, 0);
                        }
                    }
                    if (kb == 0) {
                        if (!PREK) {
#pragma unroll
                            for (int s = 0; s < NS; ++s) kf[s] = *(const bf16x8*)(kb_l + (32 + r) * KST + (koff + 8 * h) * 2 + s * 32);
                        }
                    }
                }
              }
            }
            store_tile((t + 1) & 1, D2 ? (PAR ^ 1) : 0);
            asm volatile("s_waitcnt lgkmcnt(0)" ::: "memory"); __builtin_amdgcn_s_barrier(); asm volatile("" ::: "memory");
        };
        for (int t = 0; t < 4; t += 2) { tile_body(t, false, 0); tile_body(t + 1, false, 1); }
        if (T > 4) {
            load_q(true);
            for (int t = 4; t < T; t += 2) { tile_body(t, true, 0); if (t + 1 < T) tile_body(t + 1, true, 1); }
        }
        float l_tot = l_run + bperm(l_run, x32);
        if (MODE == 1) l_tot += fexp2(a.sink[hh] * LOG2E - m_run);
        const float inv = 1.0f / l_tot;
        if (!PAIR) {
            bf16_t* op = a.ao + (size_t)tokq * 1024 + hh * DV;
#pragma unroll
            for (int d = 0; d < NDB; ++d)
#pragma unroll
                for (int g = 0; g < 4; ++g) {
                    f32x4 v = {ot[d][4 * g] * inv, ot[d][4 * g + 1] * inv, ot[d][4 * g + 2] * inv, ot[d][4 * g + 3] * inv};
                    *(u32x2*)(op + 32 * d + 8 * g + 4 * h) = pack4(v);
                }
        } else {
            float* ex = (float*)lds;
            if (gsel == 1) {
#pragma unroll
                for (int d = 0; d < NDB; ++d)
#pragma unroll
                    for (int i = 0; i < 16; ++i) ex[(wq * 128 + 32 * d + crow(i, h)) * 32 + r] = ot[d][i] * inv;
            }
            __syncthreads();
            if (gsel == 0) {
                float ss = 0.f;
#pragma unroll
                for (int d = 0; d < NDB; ++d)
#pragma unroll
                    for (int i = 0; i < 16; ++i) {
                        const float o1 = ex[(wq * 128 + 32 * d + crow(i, h)) * 32 + r];
                        const float v = ot[d][i] * inv - lam * o1;
                        ot[d][i] = v; ss += v * v;
                    }
                ss += bperm(ss, x32);
                const float rstd = rsqrtf(ss * (1.0f / 128.0f) + EPSV) * (1.0f - a.lam_init);
                bf16_t* op = a.ao + (size_t)tokq * 1024 + hh * DV;
#pragma unroll
                for (int d = 0; d < NDB; ++d)
#pragma unroll
                    for (int g = 0; g < 4; ++g) {
                        const int dd = 32 * d + 8 * g + 4 * h;
                        f32x4 gn = *(const f32x4*)(a.ng + dd);
                        f32x4 v = {ot[d][4 * g] * rstd * gn[0], ot[d][4 * g + 1] * rstd * gn[1], ot[d][4 * g + 2] * rstd * gn[2], ot[d][4 * g + 3] * rstd * gn[3]};
                        *(u32x2*)(op + dd) = pack4(v);
                    }
            }
            __syncthreads();
        }
    }
}

DI void norm_phase(float* X, const float* g, const float* mods_l, int shift_i, int scale_i, bf16_t* H, int nrows, const int tid, const float* part, int npart) {
    const int wave = tid >> 6, lane = tid & 63;
    const int gw = blockIdx.x * 8 + wave, nw = gridDim.x * 8;
    for (int row = gw; row < nrows; row += nw) {
        float* xp = X + (size_t)row * DM;
        f32x4 v[4]; float ss = 0.f;
#pragma unroll
        for (int i = 0; i < 4; ++i) v[i] = *(const f32x4*)(xp + i * 256 + lane * 4);
        if (row >= NLAT && npart > 0) {
            for (int sidx = 0; sidx < npart; ++sidx) {
                const float* pp = part + ((size_t)sidx * (MT - NLAT) + (row - NLAT)) * DM;
#pragma unroll
                for (int i = 0; i < 4; ++i) v[i] += *(const f32x4*)(pp + i * 256 + lane * 4);
            }
#pragma unroll
            for (int i = 0; i < 4; ++i) *(f32x4*)(xp + i * 256 + lane * 4) = v[i];
        }
#pragma unroll
        for (int i = 0; i < 4; ++i) ss += v[i][0] * v[i][0] + v[i][1] * v[i][1] + v[i][2] * v[i][2] + v[i][3] * v[i][3];
        ss = wave_sum(ss, lane);
        const float rstd = rsqrtf(ss * (1.0f / 1024.0f) + EPSV);
        const float* mp = mods_l + (size_t)mod_row(row) * 9216;
#pragma unroll
        for (int i = 0; i < 4; ++i) {
            const int col = i * 256 + lane * 4;
            f32x4 gg = *(const f32x4*)(g + col), sh = *(const f32x4*)(mp + shift_i * 1024 + col), sc = *(const f32x4*)(mp + scale_i * 1024 + col);
            f32x4 y = (v[i] * rstd) * gg;
            y = y * (sc + 1.0f) + sh;
            *(u32x2*)(H + (size_t)row * DM + col) = pack4(y);
        }
    }
}

DI void final_phase(const float* X, const float* g, float* out, const int tid) {
    const int wave = tid >> 6, lane = tid & 63;
    const int gw = blockIdx.x * 8 + wave, nw = gridDim.x * 8;
    for (int row = gw; row < NLAT; row += nw) {
        const float* xp = X + (size_t)row * DM;
        f32x4 v[4]; float ss = 0.f;
#pragma unroll
        for (int i = 0; i < 4; ++i) { v[i] = *(const f32x4*)(xp + i * 256 + lane * 4); ss += v[i][0] * v[i][0] + v[i][1] * v[i][1] + v[i][2] * v[i][2] + v[i][3] * v[i][3]; }
        ss = wave_sum(ss, lane);
        const float rstd = rsqrtf(ss * (1.0f / 1024.0f) + EPSV);
#pragma unroll
        for (int i = 0; i < 4; ++i) {
            const int col = i * 256 + lane * 4;
            f32x4 gg = *(const f32x4*)(g + col);
            *(f32x4*)(out + (size_t)row * DM + col) = (v[i] * rstd) * gg;
        }
    }
}

struct ConvJob { const float* src; int srcN, K, dstN, mode, coloff; const float* scale; size_t dst; };

DI int rope_dim(int w, int grp) { return (w < 16) ? grp * 16 + w : 32 + grp * 16 + (w - 16); }
DI int conv_perm(int mode, int coloff, int n) {
    switch (mode) {
    case 0: return coloff + n;
    case 1: { const int t = n >> 8, q = n & 255, bj = q >> 7, wcc = (q & 127) >> 5, nn = (q & 31) >> 4, i = q & 15;
              return (bj ? 2816 : 0) + t * 128 + wcc * 32 + (i >> 2) * 8 + nn * 4 + (i & 3); }
    case 2: { const int blk = n >> 6, grp = (n >> 5) & 1, w = n & 31; return coloff + blk * 64 + rope_dim(w, grp); }
    case 3: { if (n < 768) return n; if (n >= 832) return -1; const int rr = n - 768; return 768 + rope_dim(rr & 31, rr >> 5); }
    case 4: { const int g = n >> 5, head = g / 6, gi = g - head * 6, w = n & 31; if (gi < 4) return head * 192 + gi * 32 + w; return head * 192 + 128 + rope_dim(w, gi - 4); }
    case 5: return (n >> 7) * 256 + (n & 127);
    default: return (n >> 7) * 256 + 128 + (n & 127);
    }
}

DI ConvJob get_conv_job(const Params& p, int j) {
    ConvJob c; c.scale = nullptr; c.coloff = 0; c.mode = 0; c.K = 1024; c.srcN = 1024; c.dstN = 1024;
    if (j < 8) { c.src = p.in[8] + (size_t)j * 1024 * 5632; c.srcN = 5632; c.dstN = 5632; c.mode = 1; c.dst = W_IN + (size_t)j * 5632 * 1024; }
    else if (j < 16) { c.src = p.in[9] + (size_t)(j - 8) * 2816 * 1024; c.K = 2816; c.dst = W_OUT + (size_t)(j - 8) * 1024 * 2816; }
    else switch (j) {
    case 16: c.src = p.in[10]; c.srcN = 832; c.mode = 3; c.dst = W_MLA_DOWN; break;
    case 17: c.src = p.in[13]; c.srcN = 1536; c.K = 512; c.dstN = 1536; c.mode = 4; c.scale = p.in[11]; c.dst = W_MLA_UQ; break;
    case 18: c.src = p.in[14]; c.srcN = 2048; c.K = 256; c.mode = 5; c.scale = p.in[12]; c.dst = W_MLA_UK; break;
    case 19: c.src = p.in[14]; c.srcN = 2048; c.K = 256; c.mode = 6; c.scale = p.in[12]; c.dst = W_MLA_UV; break;
    case 20: c.src = p.in[15]; c.dst = W_MLA_WO; break;
    case 21: c.src = p.in[16]; c.srcN = 1536; c.dstN = 1280; c.mode = 2; c.dst = W_SWA_QK; break;
    case 22: c.src = p.in[16]; c.srcN = 1536; c.dstN = 256; c.coloff = 1280; c.dst = W_SWA_V; break;
    case 23: c.src = p.in[18]; c.dst = W_SWA_WO; break;
    case 24: c.src = p.in[19]; c.srcN = 3072; c.dstN = 2048; c.dst = W_NA_QK; break;
    case 25: c.src = p.in[19]; c.srcN = 3072; c.coloff = 2048; c.dst = W_NA_V; break;
    case 26: c.src = p.in[21]; c.dst = W_NA_WO; break;
    case 27: c.src = p.in[22]; c.srcN = 3072; c.dstN = 2048; c.mode = 2; c.dst = W_DIFF_QK; break;
    case 28: c.src = p.in[22]; c.srcN = 3072; c.coloff = 2048; c.dst = W_DIFF_V; break;
    default: c.src = p.in[25]; c.dst = W_DIFF_WO; break;
    }
    return c;
}
constexpr int N_CONV = 30;

DI void prep_phase(const Params& p, char* lds, const int tid) {
    bf16_t* W = (bf16_t*)(p.ws + OFF_W);
    {
        constexpr int TST = 528;
        int rot = 0;
        for (int j = 0; j < N_CONV; ++j) {
            const ConvJob c = get_conv_job(p, j);
            const int nkt = c.K / 256, units = (c.dstN / 64) * nkt;
            int first = (int)blockIdx.x - rot; if (first < 0) first += gridDim.x;
            for (int u = first; u < units; u += gridDim.x) {
                const int ntile = u / nkt, kt = u % nkt;
                const int nl = tid & 63, kk = tid >> 6;
                const int sc = conv_perm(c.mode, c.coloff, ntile * 64 + nl);
                const int k0 = kt * 256 + kk * 32;
                float v[32];
#pragma unroll
                for (int i = 0; i < 32; ++i) v[i] = (sc >= 0) ? c.src[(size_t)(k0 + i) * c.srcN + sc] : 0.f;
                if (c.scale) {
#pragma unroll
                    for (int i = 0; i < 32; ++i) v[i] *= c.scale[k0 + i];
                }
#pragma unroll
                for (int i = 0; i < 16; ++i) *(unsigned*)(lds + nl * TST + (kk * 32 + 2 * i) * 2) = pack2(v[2 * i], v[2 * i + 1]);
                __syncthreads();
#pragma unroll
                for (int i = 0; i < 4; ++i) {
                    const int idx = tid + i * NTHREADS, n = idx >> 5, ch = idx & 31;
                    u32x4 w = *(const u32x4*)(lds + n * TST + ch * 16);
                    *(u32x4*)(W + c.dst + (size_t)(ntile * 64 + n) * c.K + kt * 256 + ch * 8) = w;
                }
                __syncthreads();
            }
            rot = (rot + units) % (int)gridDim.x;
        }
    }
    {
        float* sc = (float*)lds;
        float* red = (float*)(lds + 20480);
        for (int i = tid; i < 5 * 1024; i += NTHREADS) {
            const int rr = i >> 10, k = i & 1023;
            const float cv = rr < 4 ? p.in[1][rr * 1024 + k] : p.in[3][k];
            sc[i] = siluf(cv);
        }
        __syncthreads();
        float* mods = (float*)(p.ws + OFF_MODS);
        const int c4 = tid & 31, ks = tid >> 5;
        for (int u = blockIdx.x; u < 4 * 72; u += gridDim.x) {
            const int l = u / 72, n0 = (u % 72) * 128;
            const float* wp = p.in[4] + (size_t)l * 1024 * 9216 + n0 + c4 * 4;
            f32x4 a0 = {0, 0, 0, 0}, a1 = a0, a2 = a0, a3 = a0, a4 = a0;
#pragma unroll 8
            for (int kk = 0; kk < 64; ++kk) {
                const int k = ks * 64 + kk;
                const f32x4 w = *(const f32x4*)(wp + (size_t)k * 9216);
                a0 += w * sc[k]; a1 += w * sc[1024 + k]; a2 += w * sc[2048 + k]; a3 += w * sc[3072 + k]; a4 += w * sc[4096 + k];
            }
            *(f32x4*)(red + (ks * 5 + 0) * 128 + c4 * 4) = a0; *(f32x4*)(red + (ks * 5 + 1) * 128 + c4 * 4) = a1;
            *(f32x4*)(red + (ks * 5 + 2) * 128 + c4 * 4) = a2; *(f32x4*)(red + (ks * 5 + 3) * 128 + c4 * 4) = a3;
            *(f32x4*)(red + (ks * 5 + 4) * 128 + c4 * 4) = a4;
            __syncthreads();
            for (int i = tid; i < 5 * 128; i += NTHREADS) {
                const int rr = i >> 7, cc = i & 127;
                float s = p.in[5][l * 9216 + n0 + cc];
#pragma unroll
                for (int q = 0; q < 16; ++q) s += red[(q * 5 + rr) * 128 + cc];
                mods[((size_t)l * 5 + rr) * 9216 + n0 + cc] = s;
            }
            __syncthreads();
        }
    }
    {
        float* cosT = (float*)(p.ws + OFF_COS); float* sinT = (float*)(p.ws + OFF_SIN);
        for (int i = blockIdx.x * NTHREADS + tid; i < 4096 * 32; i += gridDim.x * NTHREADS) {
            const int pos = i >> 5, d = i & 31, f = d & 15;
            const float inv = expf(-9.210340371976184f * (float)f / 16.0f);
            const float base = (d < 16) ? (float)(pos >> 6) : (float)(pos & 63);
            const float ang = base * inv;
            float rev = ang * 0.15915494309189535f; rev = rev - floorf(rev);
            cosT[i] = __builtin_amdgcn_cosf(rev); sinT[i] = __builtin_amdgcn_sinf(rev);
        }
    }
    {
        f32x4* X4 = (f32x4*)(p.ws + OFF_X);
        const f32x4* x4 = (const f32x4*)p.in[0]; const f32x4* c4p = (const f32x4*)p.in[2];
        const size_t nlat4 = (size_t)NLAT * 256, nall4 = (size_t)MT * 256;
        for (size_t i = (size_t)blockIdx.x * NTHREADS + tid; i < nall4; i += (size_t)gridDim.x * NTHREADS)
            X4[i] = i < nlat4 ? x4[i] : c4p[i - nlat4];
    }
}

constexpr int N_PHASES = 1 + 4 * 11 + 1;
__host__ __device__ inline bool phase_is_noop(int ph) {
    if (ph == 0 || ph == N_PHASES - 1) return false;
    const int layer = (ph - 1) / 11, slot = (ph - 1) % 11;
    return slot == 5 && layer != 0;
}

DI GemmJob get_job(const Params& p, int layer, int slot, int jidx, int& nj, const bool dry) {
    char* ws = p.ws;
    bf16_t* W = (bf16_t*)(ws + OFF_W);
    float* X = (float*)(ws + OFF_X);
    bf16_t* H = (bf16_t*)(ws + OFF_H);
    bf16_t* R = (bf16_t*)(ws + OFF_R);
    bf16_t* RQ = (bf16_t*)(ws + OFF_R + R_Q); bf16_t* RK = (bf16_t*)(ws + OFF_R + R_K);
    bf16_t* RVT = (bf16_t*)(ws + OFF_R + R_VT); bf16_t* RD = (bf16_t*)(ws + OFF_R + R_DRAW);
    const float* mods_l = (const float*)(ws + OFF_MODS) + (size_t)layer * 5 * 9216;
    float* stats = (float*)(ws + OFF_STATS);
    const float* cosT = (const float*)(ws + OFF_COS); const float* sinT = (const float*)(ws + OFF_SIN);
    const bool last = layer == 3;
    GemmJob j; j.o0 = j.o1 = nullptr; j.o2 = nullptr; j.f0 = j.f1 = nullptr; j.i0 = 0; j.s0 = 0.f; j.ksplit = 1; j.row0 = 0;
    if (slot == 1 || slot == 9) {
        const int f = slot == 1 ? 0 : 1;
        j.A = H; j.lda = 1024; j.B = W + W_IN + (size_t)(layer * 2 + f) * 5632 * 1024; j.ldb = 1024;
        j.M = (last && f == 1) ? NLAT : MT; j.N = 5632; j.K = 1024; j.epi = EPI_SWIGLU; j.o0 = R;
        nj = 1; return j;
    }
    if (slot == 2 || slot == 10) {
        const int f = slot == 2 ? 0 : 1;
        j.A = R; j.lda = DFF; j.B = W + W_OUT + (size_t)(layer * 2 + f) * 1024 * 2816; j.ldb = DFF;
        j.M = NLAT; j.N = 1024; j.K = DFF; j.epi = EPI_RESID; j.o0 = X;
        j.f0 = mods_l + (f == 0 ? 2 : 8) * 1024; j.s0 = 0.5f;
        nj = (last && f == 1) ? 1 : 2;
        if (dry) { nj = 1; j.s0 = 0.f; }
        if (jidx == 1) { j.A = R + (size_t)NLAT * DFF; j.M = MT - NLAT; j.row0 = NLAT; j.ksplit = 11; j.epi = EPI_RESID_ATOMIC; j.o2 = (float*)(ws + OFF_R + R_VT); }
        return j;
    }
    if (slot == 7) {
        const size_t wo = layer == 0 ? W_MLA_WO : layer == 1 ? W_SWA_WO : layer == 2 ? W_NA_WO : W_DIFF_WO;
        j.A = H; j.lda = 1024; j.B = W + wo; j.ldb = 1024; j.M = NLAT; j.N = 1024; j.K = 1024;
        j.epi = EPI_RESID; j.o0 = X; j.f0 = mods_l + 5 * 1024; j.s0 = 1.0f;
        nj = last ? 1 : 2;
        if (dry) { nj = 1; j.s0 = 0.f; }
        if (jidx == 1) { j.A = H + (size_t)NLAT * 1024; j.M = MT - NLAT; j.row0 = NLAT; j.ksplit = 4; j.epi = EPI_RESID_ATOMIC; j.o2 = (float*)(ws + OFF_R + R_DRAW); }
        return j;
    }
    if (slot == 4) {
        if (layer == 0) {
            j.A = H; j.lda = 1024; j.B = W + W_MLA_DOWN; j.ldb = 1024; j.M = MT; j.N = 1024; j.K = 1024;
            j.epi = EPI_MLA_DOWN; j.o0 = RD; j.o1 = RK; j.o2 = stats; j.f0 = cosT; j.f1 = sinT;
            nj = 1; return j;
        }
        j.A = H; j.lda = 1024; j.ldb = 1024; j.M = MT; j.K = 1024; j.o0 = RQ; j.o1 = RK;
        if (layer == 1) { j.B = W + W_SWA_QK; j.N = 1280; j.epi = EPI_ROPE; j.i0 = 16; j.f0 = cosT; j.f1 = sinT; }
        else if (layer == 2) { j.B = W + W_NA_QK; j.N = 2048; j.epi = EPI_PLAIN2; }
        else { j.B = W + W_DIFF_QK; j.N = 2048; j.epi = EPI_ROPE; j.i0 = 16; j.f0 = cosT; j.f1 = sinT; }
        nj = 2;
        if (jidx == 0) return j;
        GemmJob v; v.o1 = nullptr; v.o2 = nullptr; v.f0 = v.f1 = nullptr; v.i0 = 0; v.s0 = 0.f; v.ksplit = 1; v.row0 = 0;
        v.A = W + (layer == 1 ? W_SWA_V : layer == 2 ? W_NA_V : W_DIFF_V); v.lda = 1024; v.B = H; v.ldb = 1024;
        v.M = layer == 1 ? 256 : 1024; v.N = MT; v.K = 1024; v.epi = EPI_VT; v.o0 = RVT;
        return v;
    }
    j.A = RD; j.lda = 1024; j.B = W + W_MLA_UQ; j.ldb = 512; j.M = MT; j.N = 1536; j.K = 512;
    j.epi = EPI_MLA_Q; j.o0 = RQ; j.o1 = (void*)cosT; j.f0 = stats; j.f1 = sinT;
    nj = 3;
    if (jidx == 0) return j;
    GemmJob k = j; k.A = RD + 512; k.B = W + W_MLA_UK; k.ldb = 256; k.N = 1024; k.K = 256; k.epi = EPI_MLA_K; k.o0 = RK; k.o1 = nullptr; k.f1 = nullptr;
    if (jidx == 1) return k;
    GemmJob v = k; v.A = W + W_MLA_UV; v.lda = 256; v.B = RD + 512; v.ldb = 1024; v.M = 1024; v.N = MT; v.epi = EPI_VT; v.o0 = RVT; v.i0 = 1;
    return v;
}

DI void run_phase(const Params& p, int ph, char* lds, const int wave_s, const bool dry = false) {
    char* ws = p.ws;
    float* X = (float*)(ws + OFF_X);
    bf16_t* H = (bf16_t*)(ws + OFF_H);
#ifndef NO_PREP
    if (ph == 0) { prep_phase(p, lds, fresh_tid(wave_s)); return; }
#endif
    if (ph == N_PHASES - 1) { final_phase(X, p.in[7], p.out, fresh_tid(wave_s)); return; }
    const int layer = (ph - 1) / 11, slot = (ph - 1) % 11;
    const float* mods_l = (const float*)(ws + OFF_MODS) + (size_t)layer * 5 * 9216;
    const bool last = layer == 3;
    if (slot == 0 || slot == 3 || slot == 8) {
        const int sub = slot == 0 ? 0 : slot == 3 ? 1 : 2;
        const float* part = (sub == 2) ? (const float*)(ws + OFF_R + R_DRAW) : (const float*)(ws + OFF_R + R_VT);
        const int npart = (sub == 2) ? 4 : ((sub == 0 && layer == 0) ? 0 : 11);
        norm_phase(X, p.in[6] + (size_t)(layer * 3 + sub) * 1024, mods_l, sub * 3, sub * 3 + 1, H, (last && sub == 2) ? NLAT : MT, fresh_tid(wave_s), part, (last && sub == 2) ? 0 : npart);
        return;
    }
#ifndef NO_ATTN
    if (slot == 6) {
        const int tid = fresh_tid(wave_s);
        AttnArgs a;
        a.q = (const bf16_t*)(ws + OFF_R + R_Q); a.k = (const bf16_t*)(ws + OFF_R + R_K); a.vt = (const bf16_t*)(ws + OFF_R + R_VT);
        a.ao = H; a.sink = nullptr; a.rpb = nullptr; a.lamp = nullptr; a.ng = nullptr; a.lam_init = 0.f; a.ctx_units = last ? 0 : 1;
        if (layer == 0) {
            a.q_ts = 2048; a.q_hs = 256; a.q_rot = 128; a.q_plain = 192; a.k_ts = 1536; a.k_hs = 192; a.NH = 8; a.scale = 0.07216878364870322f;
            attn_phase<192, 128, 0, false>(a, lds, tid);
        } else if (layer == 1) {
            a.q_ts = 2048; a.q_hs = 128; a.q_rot = 0; a.q_plain = 64; a.k_ts = 256; a.k_hs = 64; a.NH = 16; a.scale = 0.125f; a.sink = p.in[17];
            attn_phase<64, 64, 1, false>(a, lds, tid);
        } else if (layer == 2) {
            a.q_ts = 1024; a.q_hs = 64; a.q_rot = 0; a.q_plain = 0; a.k_ts = 1024; a.k_hs = 64; a.NH = 16; a.scale = 0.125f; a.rpb = p.in[20];
            attn_phase<64, 64, 2, false>(a, lds, tid);
        } else {
            a.q_ts = 2048; a.q_hs = 128; a.q_rot = 0; a.q_plain = 64; a.k_ts = 1024; a.k_hs = 128; a.NH = 8; a.scale = 0.125f;
            a.lamp = p.in[23]; a.ng = p.in[24]; a.lam_init = 0.5560582f;
            attn_phase<64, 128, 0, true>(a, lds, tid);
        }
        return;
    }
#endif
#ifndef NO_GEMM
    int nj = 1, rot = 0;
#pragma unroll 1
    for (int j = 0; j < nj; ++j) {
        const GemmJob job = get_job(p, layer, slot, j, nj, dry);
        gemm_run(job, lds, wave_s, rot);
        rot = (rot + (job.M / BM) * (job.N / BM) * job.ksplit) % (int)gridDim.x;
    }
#endif
}

__global__ void __launch_bounds__(NTHREADS) mega_kernel(Params p, int ph_lo, int ph_hi) {
    extern __shared__ __attribute__((aligned(16))) char lds[];
    cg::grid_group grid = cg::this_grid();
    const int wave_s = __builtin_amdgcn_readfirstlane(threadIdx.x >> 6);
    if (ph_lo > ph_hi) grid.sync();
    XcdBarrier xb; xb.bar = (unsigned*)(p.ws + OFF_BAR); xb.x = xb_xcc_id(); xb.st = (volatile LAS unsigned*)&lds[131072];
    if (ph_hi - ph_lo > 1) {
        const bool t0 = fresh_tid(wave_s) == 0;
        if (t0) { xb.st[0] = 0u; xb.st[1] = 0u; }
        __syncthreads();
        if (t0) (void)xb_add(&xb.bar[XB_XCNT(xb.x)], 1u);
    }
#pragma unroll 1
    for (int ph = ph_lo; ph < ph_hi; ++ph) {
        if (phase_is_noop(ph)) continue;
        run_phase(p, ph, lds, wave_s);
        if (PROBE_DUP) {
            const int slot_ = (ph >= 1 && ph < N_PHASES - 1) ? (ph - 1) % 11 : -1;
            bool dup = false;
            if (PROBE_DUP == 1) dup = ph == 0;
            if (PROBE_DUP == 3) dup = slot_ == 6;
            if (PROBE_DUP >= 30 && PROBE_DUP < 34) dup = slot_ == 6 && (ph - 1) / 11 == PROBE_DUP - 30;
            if (PROBE_DUP == 4) dup = slot_ == 0 || slot_ == 3 || slot_ == 8;
            if (PROBE_DUP == 5) dup = slot_ == 1 || slot_ == 9;
            if (PROBE_DUP == 6) dup = slot_ == 4 || slot_ == 5;
            if (PROBE_DUP == 7) dup = slot_ == 2 || slot_ == 10;
            if (PROBE_DUP == 8) dup = slot_ == 7;
            if (PROBE_DUP == 2) xcd_barrier(xb, fresh_tid(wave_s) == 0);
            if (dup) { xcd_barrier(xb, fresh_tid(wave_s) == 0); run_phase(p, ph, lds, wave_s, PROBE_DUP >= 7); }
        }
        if (ph + 1 < ph_hi) xcd_barrier(xb, fresh_tid(wave_s) == 0);
    }
}

extern "C" void kernel_launch(void* const* d_in, const int* in_sizes, int n_in, void* d_out, int out_size, void* d_ws, size_t ws_size,
                              hipStream_t stream) {
    static int grid_blocks = 0;
    if (!grid_blocks) {
        (void)hipFuncSetAttribute((const void*)mega_kernel, hipFuncAttributeMaxDynamicSharedMemorySize, LDS_BYTES);
        int dev = 0, cus = 0, per_cu = 0;
        (void)hipGetDevice(&dev);
        (void)hipDeviceGetAttribute(&cus, hipDeviceAttributeMultiprocessorCount, dev);
        (void)hipOccupancyMaxActiveBlocksPerMultiprocessor(&per_cu, mega_kernel, NTHREADS, LDS_BYTES);
        if (per_cu < 1) per_cu = 1;
        if (per_cu > 1) per_cu = 1;
        grid_blocks = cus * per_cu;
        grid_blocks -= grid_blocks % 8;
        if (ws_size < WS_NEED) fprintf(stderr, "workspace too small: %zu < %zu\n", ws_size, (size_t)WS_NEED);
    }
    Params p{};
    for (int i = 0; i < 26; ++i) p.in[i] = (const float*)d_in[i];
    p.out = (float*)d_out; p.ws = (char*)d_ws;
#if MK_SINGLE
    (void)hipMemsetAsync((char*)d_ws + OFF_BAR, 0, 16384, stream);
    int lo = 0, hi = N_PHASES;
    void* args[] = {&p, &lo, &hi};
    hipError_t e = hipLaunchCooperativeKernel((const void*)mega_kernel, dim3(grid_blocks), dim3(NTHREADS), args, LDS_BYTES, stream);
    if (e != hipSuccess) fprintf(stderr, "cooperative launch failed: %s (grid %d)\n", hipGetErrorString(e), grid_blocks);
#else
    for (int ph = 0; ph < N_PHASES; ++ph) {
        if (phase_is_noop(ph)) continue;
        mega_kernel<<<dim3(grid_blocks), dim3(NTHREADS), LDS_BYTES, stream>>>(p, ph, ph + 1);
    }
#endif
}
```

```cpp
#include <hip/hip_runtime.h>
#include <hip/hip_cooperative_groups.h>
#include <cstdio>
#include <cstdint>
namespace cg = cooperative_groups;

#ifndef MK_SINGLE
#define MK_SINGLE 1
#endif
#define PROBE_DUP 0

typedef unsigned short bf16_t;
typedef short bf16x8 __attribute__((ext_vector_type(8)));
typedef short s16x4 __attribute__((ext_vector_type(4)));
typedef float f32x4 __attribute__((ext_vector_type(4)));
typedef float f32x2 __attribute__((ext_vector_type(2)));
typedef float f32x16 __attribute__((ext_vector_type(16)));
typedef unsigned u32x4 __attribute__((ext_vector_type(4)));
typedef unsigned u32x2 __attribute__((ext_vector_type(2)));
typedef __bf16 bf2_t __attribute__((ext_vector_type(2)));
#define DI __device__ __forceinline__

constexpr int MT = 17408;
constexpr int NLAT = 16384;
constexpr int DM = 1024;
constexpr int DFF = 2816;
constexpr int NTHREADS = 512;
constexpr int LDS_BYTES = 131072 + 16;
constexpr float EPSV = 1e-6f;
constexpr float LOG2E = 1.4426950408889634f;
constexpr float RESCALE_THR = 8.0f;

constexpr size_t al256(size_t x) { return (x + 255) & ~(size_t)255; }
constexpr size_t OFF_BAR = 0;
constexpr size_t OFF_MODS = 16384;
constexpr size_t OFF_COS = al256(OFF_MODS + (size_t)4 * 5 * 9216 * 4);
constexpr size_t OFF_SIN = al256(OFF_COS + (size_t)4096 * 32 * 4);
constexpr size_t OFF_STATS = al256(OFF_SIN + (size_t)4096 * 32 * 4);
constexpr size_t OFF_X = al256(OFF_STATS + (size_t)MT * 16 * 4);
constexpr size_t OFF_H = al256(OFF_X + (size_t)MT * 1024 * 4);
constexpr size_t OFF_W = al256(OFF_H + (size_t)MT * 1024 * 2);
constexpr size_t W_IN = 0;
constexpr size_t W_OUT = W_IN + (size_t)8 * 5632 * 1024;
constexpr size_t W_MLA_DOWN = W_OUT + (size_t)8 * 1024 * 2816;
constexpr size_t W_MLA_UQ = W_MLA_DOWN + (size_t)1024 * 1024;
constexpr size_t W_MLA_UK = W_MLA_UQ + (size_t)1536 * 512;
constexpr size_t W_MLA_UV = W_MLA_UK + (size_t)1024 * 256;
constexpr size_t W_MLA_WO = W_MLA_UV + (size_t)1024 * 256;
constexpr size_t W_SWA_QK = W_MLA_WO + (size_t)1024 * 1024;
constexpr size_t W_SWA_V = W_SWA_QK + (size_t)1280 * 1024;
constexpr size_t W_SWA_WO = W_SWA_V + (size_t)256 * 1024;
constexpr size_t W_NA_QK = W_SWA_WO + (size_t)1024 * 1024;
constexpr size_t W_NA_V = W_NA_QK + (size_t)2048 * 1024;
constexpr size_t W_NA_WO = W_NA_V + (size_t)1024 * 1024;
constexpr size_t W_DIFF_QK = W_NA_WO + (size_t)1024 * 1024;
constexpr size_t W_DIFF_V = W_DIFF_QK + (size_t)2048 * 1024;
constexpr size_t W_DIFF_WO = W_DIFF_V + (size_t)1024 * 1024;
constexpr size_t W_TOTAL = W_DIFF_WO + (size_t)1024 * 1024;
constexpr size_t OFF_R = al256(OFF_W + W_TOTAL * 2);
constexpr size_t R_Q = 0;
constexpr size_t R_K = al256(R_Q + (size_t)MT * 2048 * 2);
constexpr size_t R_VT = al256(R_K + (size_t)MT * 1536 * 2);
constexpr size_t R_DRAW = al256(R_VT + (size_t)1024 * MT * 2);
constexpr size_t R_END = al256(R_DRAW + (size_t)MT * 1024 * 2);
constexpr size_t WS_NEED = OFF_R + R_END;

struct Params {
    const float* in[26];
    float* out;
    char* ws;
};

DI unsigned pack2(float lo, float hi) {
    f32x2 v = {lo, hi};
    bf2_t b = __builtin_convertvector(v, bf2_t);
    return __builtin_bit_cast(unsigned, b);
}
DI u32x2 pack4(f32x4 v) { u32x2 r; r.x = pack2(v[0], v[1]); r.y = pack2(v[2], v[3]); return r; }
DI float fexp2(float x) { return __builtin_amdgcn_exp2f(x); }
DI float siluf(float g) { return g * __builtin_amdgcn_rcpf(1.0f + __builtin_amdgcn_exp2f(-g * LOG2E)); }
DI int mod_row(int row) { return row < NLAT ? (row >> 12) : 4; }
template <int M> DI float swz_xor(float x) { return __int_as_float(__builtin_amdgcn_ds_swizzle(__float_as_int(x), (M << 10) | 0x1f)); }
DI float max_x32(float x) {
    auto r = __builtin_amdgcn_permlane32_swap(__float_as_uint(x), __float_as_uint(x), false, false);
    return fmaxf(__uint_as_float(r[0]), __uint_as_float(r[1]));
}
DI float bperm(float x, int addr) { return __int_as_float(__builtin_amdgcn_ds_bpermute(addr, __float_as_int(x))); }
DI float wave_sum(float x, int lane) {
    x += bperm(x, (lane ^ 32) << 2);
    x += swz_xor<16>(x); x += swz_xor<8>(x); x += swz_xor<4>(x); x += swz_xor<2>(x); x += swz_xor<1>(x);
    return x;
}
DI int fresh_tid(int wave_s) {
    int lane;
    asm volatile("v_mbcnt_lo_u32_b32 %0, -1, 0\n\tv_mbcnt_hi_u32_b32 %0, -1, %0" : "=v"(lane));
    return wave_s * 64 + lane;
}


#define XB_TMO      128
#define XB_XCNT(j)  (256  + 64 * (j))
#define XB_XSUB(j)  (1280 + 64 * (j))
#define XB_XGEN(j)  (2304 + 64 * (j))
#define XB_TOP      3328
#define XB_TOPGEN   3392
#define XCD_BAR_WORDS 3456
#define XB_SPIN_CAP (1u << 18)
#define LAS __attribute__((address_space(3)))
DI unsigned xb_ld(unsigned* p) { return __hip_atomic_load(p, __ATOMIC_RELAXED, __HIP_MEMORY_SCOPE_AGENT); }
DI unsigned xb_add(unsigned* p, unsigned v) { return __hip_atomic_fetch_add(p, v, __ATOMIC_RELAXED, __HIP_MEMORY_SCOPE_AGENT); }
DI unsigned xb_xcc_id() { return (unsigned)__builtin_amdgcn_s_getreg((3 << 11) | 20) & 0xFu; }
#define XB_SPIN(cond, bar) do { unsigned _sp = 0; while (cond) { __builtin_amdgcn_s_sleep(1); \
    if ((++_sp & 255u) == 0u) { if (xb_ld(&(bar)[XB_TMO])) break; if (_sp > XB_SPIN_CAP) { atomicAdd(&(bar)[XB_TMO], 1u); break; } } } } while (0)
struct XcdBarrier { unsigned* bar; unsigned x; volatile LAS unsigned* st; };
DI void xcd_barrier_complete(unsigned* bar, unsigned x, unsigned& nloc, unsigned& nx) {
    const unsigned G = gridDim.x * gridDim.y * gridDim.z;
    unsigned sum, cnt, mine, sp = 0u;
    for (;;) {
        sum = 0u; cnt = 0u; mine = 0u;
#pragma unroll
        for (unsigned j = 0; j < 16; ++j) { const unsigned c = xb_ld(&bar[XB_XCNT(j)]); sum += c; cnt += (c > 0u) ? 1u : 0u; mine = (j == x) ? c : mine; }
        if (sum == G) break;
        __builtin_amdgcn_s_sleep(1);
        if ((++sp & 255u) == 0u) { if (xb_ld(&bar[XB_TMO])) break; if (sp > XB_SPIN_CAP) { atomicAdd(&bar[XB_TMO], 1u); break; } }
    }
    nloc = mine > 0u ? mine : 1u; nx = cnt > 0u ? cnt : 1u;
}
DI void xcd_barrier(const XcdBarrier& b, const bool leader_thread) {
    asm volatile("s_waitcnt vmcnt(0)" ::: "memory");
    __syncthreads();
    if (leader_thread) {
        unsigned* bar = b.bar;
        __builtin_amdgcn_s_waitcnt(0);
        unsigned nloc = b.st[0], nx = b.st[1];
        if (nloc == 0u) { xcd_barrier_complete(bar, b.x, nloc, nx); b.st[0] = nloc; b.st[1] = nx; }
        const unsigned old = xb_add(&bar[XB_XSUB(b.x)], 1u);
        const unsigned gen = old / nloc;
        if (old + 1u == (gen + 1u) * nloc) {
            __builtin_amdgcn_fence(__ATOMIC_RELEASE, "agent");
            asm volatile("s_waitcnt vmcnt(0)" ::: "memory");
            const unsigned og = xb_add(&bar[XB_TOP], 1u);
            const unsigned tg = og / nx;
            if (og + 1u == (tg + 1u) * nx) xb_add(&bar[XB_TOPGEN], 1u);
            else XB_SPIN(xb_ld(&bar[XB_TOPGEN]) == tg, bar);
            __builtin_amdgcn_fence(__ATOMIC_ACQUIRE, "agent");
            xb_add(&bar[XB_XGEN(b.x)], 1u);
            asm volatile("s_waitcnt vmcnt(0)" ::: "memory");
        } else {
            XB_SPIN(xb_ld(&bar[XB_XGEN(b.x)]) == gen, bar);
            __builtin_amdgcn_fence(__ATOMIC_ACQUIRE, "agent");
            asm volatile("s_waitcnt vmcnt(0)" ::: "memory");
        }
    }
    __syncthreads();
}

constexpr int BM = 256, BK = 64, HALF = 128, HT = HALF * BK;
DI int lds_byte(int r, int c) {
    int st = (r >> 4) * 2 + (c >> 5), rr = r & 15, cc = c & 31, ob = rr * 64 + cc * 2;
    return st * 1024 + (ob ^ (((ob >> 9) & 1) << 5));
}
DI void stage_rc(int b, int& R, int& C) {
    int st = b / 1024, sb = b % 1024, swz = sb ^ (((sb >> 9) & 1) << 5);
    R = (st >> 1) * 16 + swz / 64; C = (st & 1) * 32 + (swz % 64) / 2;
}

enum { EPI_RESID = 0, EPI_RESID_ATOMIC, EPI_SWIGLU, EPI_PLAIN2, EPI_ROPE, EPI_MLA_DOWN, EPI_MLA_Q, EPI_MLA_K, EPI_VT };

struct GemmJob {
    const bf16_t* A; const bf16_t* B; int lda, ldb, M, N, K, epi;
    void* o0; void* o1; float* o2; const float* f0; const float* f1; int i0; float s0; int ksplit, row0;
};

DI void gemm_epilogue(const GemmJob& J, f32x4 (&acc)[2][2][4][2], int brow, int bcol, int wr, int wc, int fr, int fq, int ks) {
    const int epi = J.epi;
    if (epi == EPI_RESID) {
        const float* gp = J.f0 + (size_t)mod_row(brow) * 9216;
        const float cf = J.s0;
        f32x4 gv[2][2];
#pragma unroll
        for (int bj = 0; bj < 2; ++bj)
#pragma unroll
            for (int n = 0; n < 2; ++n) gv[bj][n] = *(const f32x4*)(gp + bcol + bj * HALF + wc * 32 + n * 16 + fq * 4) * cf;
#pragma unroll
        for (int ai = 0; ai < 2; ++ai) {
            f32x4 xv[4][2][2];
#pragma unroll
            for (int m = 0; m < 4; ++m) {
                const float* xp = (const float*)J.o0 + (size_t)(brow + ai * HALF + wr * 64 + m * 16 + fr) * DM + bcol + wc * 32 + fq * 4;
#pragma unroll
                for (int bj = 0; bj < 2; ++bj)
#pragma unroll
                    for (int n = 0; n < 2; ++n) xv[m][bj][n] = *(const f32x4*)(xp + bj * HALF + n * 16);
            }
            __builtin_amdgcn_sched_barrier(0);
#pragma unroll
            for (int m = 0; m < 4; ++m) {
                float* xp = (float*)J.o0 + (size_t)(brow + ai * HALF + wr * 64 + m * 16 + fr) * DM + bcol + wc * 32 + fq * 4;
#pragma unroll
                for (int bj = 0; bj < 2; ++bj)
#pragma unroll
                    for (int n = 0; n < 2; ++n) *(f32x4*)(xp + bj * HALF + n * 16) = xv[m][bj][n] + gv[bj][n] * acc[ai][bj][m][n];
            }
            __builtin_amdgcn_sched_barrier(0);
        }
        return;
    }
#pragma unroll
    for (int ai = 0; ai < 2; ++ai)
#pragma unroll
        for (int m = 0; m < 4; ++m) {
            const int row = brow + ai * HALF + wr * 64 + m * 16 + fr;
            if (epi == EPI_RESID) {
                const float* gp = J.f0 + (size_t)mod_row(row) * 9216;
                float* xp = (float*)J.o0 + (size_t)row * DM;
                const float cf = J.s0;
#pragma unroll
                for (int bj = 0; bj < 2; ++bj)
#pragma unroll
                    for (int n = 0; n < 2; ++n) {
                        const int col = bcol + bj * HALF + wc * 32 + n * 16 + fq * 4;
                        f32x4 g = *(const f32x4*)(gp + col);
                        f32x4 x = *(const f32x4*)(xp + col);
                        x += (g * cf) * acc[ai][bj][m][n];
                        *(f32x4*)(xp + col) = x;
                    }
            } else if (epi == EPI_RESID_ATOMIC) {
                const float* gp = J.f0 + (size_t)mod_row(row) * 9216;
                float* pp = J.o2 + ((size_t)ks * (MT - NLAT) + (row - NLAT)) * DM;
                const float cf = J.s0;
#pragma unroll
                for (int bj = 0; bj < 2; ++bj)
#pragma unroll
                    for (int n = 0; n < 2; ++n) {
                        const int col = bcol + bj * HALF + wc * 32 + n * 16 + fq * 4;
                        f32x4 g = *(const f32x4*)(gp + col);
                        *(f32x4*)(pp + col) = (g * cf) * acc[ai][bj][m][n];
                    }
            } else if (epi == EPI_SWIGLU) {
                bf16_t* op = (bf16_t*)J.o0 + (size_t)row * DFF + (bcol >> 1) + wc * 32 + fq * 8;
                f32x4 o0, o1;
#pragma unroll
                for (int j = 0; j < 4; ++j) { o0[j] = siluf(acc[ai][0][m][0][j]) * acc[ai][1][m][0][j]; o1[j] = siluf(acc[ai][0][m][1][j]) * acc[ai][1][m][1][j]; }
                u32x4 w; { const u32x2 a = pack4(o0), b = pack4(o1); w.x = a.x; w.y = a.y; w.z = b.x; w.w = b.y; }
                *(u32x4*)op = w;
            } else if (epi == EPI_PLAIN2) {
                bf16_t* q = (bf16_t*)J.o0 + (size_t)row * 1024;
                bf16_t* k = (bf16_t*)J.o1 + (size_t)row * 1024;
#pragma unroll
                for (int bj = 0; bj < 2; ++bj)
#pragma unroll
                    for (int n = 0; n < 2; ++n) {
                        const int col = bcol + bj * HALF + wc * 32 + n * 16 + fq * 4;
                        bf16_t* d = col < 1024 ? q + col : k + (col - 1024);
                        *(u32x2*)d = pack4(acc[ai][bj][m][n]);
                    }
            } else if (epi == EPI_ROPE) {
                const int NQH = J.i0, NKH = (J.N >> 6) - NQH;
                const bool latent = row < NLAT;
                const int pos = row & 4095;
#pragma unroll
                for (int bj = 0; bj < 2; ++bj) {
                    const int gcol = bcol + bj * HALF + wc * 32;
                    const int head64 = gcol >> 6, di = ((gcol >> 5) & 1) * 16 + fq * 4;
                    f32x4 v0 = acc[ai][bj][m][0], v1 = acc[ai][bj][m][1], r1 = v0, r2 = v1;
                    if (latent) {
                        f32x4 c4 = *(const f32x4*)(J.f0 + pos * 32 + di), s4 = *(const f32x4*)(J.f1 + pos * 32 + di);
                        r1 = v0 * c4 - v1 * s4; r2 = v0 * s4 + v1 * c4;
                    }
                    if (head64 < NQH) {
                        bf16_t* q = (bf16_t*)J.o0 + (size_t)row * (NQH * 128) + head64 * 128;
                        *(u32x2*)(q + 64 + di) = pack4(v0); *(u32x2*)(q + 96 + di) = pack4(v1);
                        *(u32x2*)(q + di) = pack4(r1); *(u32x2*)(q + 32 + di) = pack4(r2);
                    } else {
                        bf16_t* k = (bf16_t*)J.o1 + (size_t)row * (NKH * 64) + (head64 - NQH) * 64;
                        *(u32x2*)(k + di) = pack4(r1); *(u32x2*)(k + 32 + di) = pack4(r2);
                    }
                }
            } else if (epi == EPI_MLA_DOWN) {
                const int pn = bcol >> 8;
                if (pn < 3) {
                    bf16_t* d = (bf16_t*)J.o0 + (size_t)row * 1024;
                    float ss = 0.f;
#pragma unroll
                    for (int bj = 0; bj < 2; ++bj)
#pragma unroll
                        for (int n = 0; n < 2; ++n) {
                            const int col = bcol + bj * HALF + wc * 32 + n * 16 + fq * 4;
                            f32x4 v = acc[ai][bj][m][n];
                            ss += v[0] * v[0] + v[1] * v[1] + v[2] * v[2] + v[3] * v[3];
                            *(u32x2*)(d + col) = pack4(v);
                        }
                    ss += swz_xor<16>(ss); ss += bperm(ss, ((fq * 16 + fr) ^ 32) << 2);
                    if (fq == 0) J.o2[(size_t)row * 16 + pn * 4 + wc] = ss;
                } else if (wc < 2) {
                    const bool latent = row < NLAT;
                    const int pos = row & 4095, di = wc * 16 + fq * 4;
                    f32x4 v0 = acc[ai][0][m][0], v1 = acc[ai][0][m][1], r1 = v0, r2 = v1;
                    if (latent) {
                        f32x4 c4 = *(const f32x4*)(J.f0 + pos * 32 + di), s4 = *(const f32x4*)(J.f1 + pos * 32 + di);
                        r1 = v0 * c4 - v1 * s4; r2 = v0 * s4 + v1 * c4;
                    }
                    u32x2 p1 = pack4(r1), p2 = pack4(r2);
                    bf16_t* k = (bf16_t*)J.o1 + (size_t)row * 1536 + 128 + di;
#pragma unroll
                    for (int hh = 0; hh < 8; ++hh) { *(u32x2*)(k + hh * 192) = p1; *(u32x2*)(k + hh * 192 + 32) = p2; }
                }
            } else if (epi == EPI_MLA_Q) {
                const float* sp = J.f0 + (size_t)row * 16;
                f32x4 a = *(const f32x4*)sp, b = *(const f32x4*)(sp + 4);
                const float rstd = rsqrtf((a[0] + a[1] + a[2] + a[3] + b[0] + b[1] + b[2] + b[3]) * (1.0f / 512.0f) + EPSV);
                const bool latent = row < NLAT;
                const int pos = row & 4095;
                const float* cosT = (const float*)J.o1; const float* sinT = J.f1;
#pragma unroll
                for (int bj = 0; bj < 2; ++bj) {
                    const int g = (bcol + bj * HALF + wc * 32) >> 5;
                    const int head = g / 6, gi = g - head * 6;
                    bf16_t* q = (bf16_t*)J.o0 + (size_t)row * 2048 + head * 256;
                    f32x4 v0 = acc[ai][bj][m][0] * rstd, v1 = acc[ai][bj][m][1] * rstd;
                    if (gi < 4) {
                        *(u32x2*)(q + gi * 32 + fq * 4) = pack4(v0); *(u32x2*)(q + gi * 32 + 16 + fq * 4) = pack4(v1);
                    } else {
                        const int di = (gi - 4) * 16 + fq * 4;
                        *(u32x2*)(q + 192 + di) = pack4(v0); *(u32x2*)(q + 224 + di) = pack4(v1);
                        if (latent) {
                            f32x4 c4 = *(const f32x4*)(cosT + pos * 32 + di), s4 = *(const f32x4*)(sinT + pos * 32 + di);
                            *(u32x2*)(q + 128 + di) = pack4(v0 * c4 - v1 * s4); *(u32x2*)(q + 160 + di) = pack4(v0 * s4 + v1 * c4);
                        }
                    }
                }
            } else if (epi == EPI_MLA_K) {
                f32x4 a = *(const f32x4*)(J.f0 + (size_t)row * 16 + 8);
                const float rstd = rsqrtf((a[0] + a[1] + a[2] + a[3]) * (1.0f / 256.0f) + EPSV);
                bf16_t* k = (bf16_t*)J.o0 + (size_t)row * 1536;
#pragma unroll
                for (int bj = 0; bj < 2; ++bj)
#pragma unroll
                    for (int n = 0; n < 2; ++n) {
                        const int col = bcol + bj * HALF + wc * 32 + n * 16 + fq * 4;
                        *(u32x2*)(k + (col >> 7) * 192 + (col & 127)) = pack4(acc[ai][bj][m][n] * rstd);
                    }
            } else {
                bf16_t* vt = (bf16_t*)J.o0 + (size_t)row * MT;
#pragma unroll
                for (int bj = 0; bj < 2; ++bj)
#pragma unroll
                    for (int n = 0; n < 2; ++n) {
                        const int col = bcol + bj * HALF + wc * 32 + n * 16 + fq * 4;
                        f32x4 v = acc[ai][bj][m][n];
                        if (J.i0) {
#pragma unroll
                            for (int j = 0; j < 4; ++j) {
                                f32x4 a = *(const f32x4*)(J.f0 + (size_t)(col + j) * 16 + 8);
                                v[j] *= rsqrtf((a[0] + a[1] + a[2] + a[3]) * (1.0f / 256.0f) + EPSV);
                            }
                        }
                        *(u32x2*)(vt + col) = pack4(v);
                    }
            }
            __builtin_amdgcn_sched_barrier(0);
        }
}

DI void gemm_run(const GemmJob& J, char* lds, const int tid_in, const int rot) {
    bf16_t* shm = (bf16_t*)lds;
    const int lda = J.lda, ldb = J.ldb, ksplit = J.ksplit;
    const __amdgpu_buffer_rsrc_t rs_A = __builtin_amdgcn_make_buffer_rsrc((void*)J.A, 0, 0x7fffffff, 0x00020000);
    const __amdgpu_buffer_rsrc_t rs_Bt = __builtin_amdgcn_make_buffer_rsrc((void*)J.B, 0, 0x7fffffff, 0x00020000);
#define SA(b, h) (shm + ((b) * 2 + (h)) * HT)
#define SB(b, h) (shm + (4 + (b) * 2 + (h)) * HT)
#define STAGE(P, BASE, OFF, LD, br, kt) do { const int _so = ((br) * (LD) + (kt) * BK) * 2 + kbyte; \
    for (int _i = 0; _i < 2; ++_i) { \
      __builtin_amdgcn_raw_ptr_buffer_load_lds(rs_##BASE, \
        (__attribute__((address_space(3))) unsigned*)((char*)(P) + tid_in * 1024 + _i * 8192), 16, OFF[_i], _so, 0, 0); } } while (0)
#define LDA(dst, b, h) for (int m = 0; m < 4; ++m) for (int k = 0; k < 2; ++k) \
    dst[m][k] = *reinterpret_cast<const bf16x8*>((char*)SA(b, h) + lds_byte(wr * 64 + m * 16 + fr, k * 32 + fq * 8))
#define LDB(dst, b, h) for (int n = 0; n < 2; ++n) for (int k = 0; k < 2; ++k) \
    dst[n][k] = *reinterpret_cast<const bf16x8*>((char*)SB(b, h) + lds_byte(wc * 32 + n * 16 + fr, k * 32 + fq * 8))
#define MMA(ai, bj, At_, Bt_) do { __builtin_amdgcn_s_setprio(1); \
    for (int m = 0; m < 4; ++m) for (int n = 0; n < 2; ++n) for (int k = 0; k < 2; ++k) \
      acc[ai][bj][m][n] = __builtin_amdgcn_mfma_f32_16x16x32_bf16(Bt_[n][k], At_[m][k], acc[ai][bj][m][n], 0, 0, 0); \
    __builtin_amdgcn_s_setprio(0); } while (0)
#define WAIT_V(n) asm volatile("s_waitcnt vmcnt(" #n ")" ::: "memory")
#define WAIT_L(n) asm volatile("s_waitcnt lgkmcnt(" #n ")" ::: "memory")
#define BAR __builtin_amdgcn_s_barrier()
#define SCHED __builtin_amdgcn_sched_barrier(0)
    const int nM = J.M / BM, nN = J.N / BM, nwg = nM * nN * J.ksplit;
    const int nt = J.K / J.ksplit / BK;
    for (int it = 0;; ++it) {
        int cshift = (int)blockIdx.x - rot; if (cshift < 0) cshift += gridDim.x;
        const long L = (long)it * gridDim.x + cshift;
        if (L >= nwg) break;
        const int tid = fresh_tid(tid_in);
        const int wid = tid >> 6, lane = tid & 63, wr = wid >> 2, wc = wid & 3, fr = lane & 15, fq = lane >> 4;
        unsigned offA[2], offB[2];
#pragma unroll
        for (int i = 0; i < 2; ++i) { int r_, c_; stage_rc(tid * 16 + i * 8192, r_, c_); offA[i] = (unsigned)(r_ * lda + c_) * 2u; offB[i] = (unsigned)(r_ * ldb + c_) * 2u; }
        int pm, pn, kbyte = 0, ksel = 0;
        if (ksplit > 1) {
            const int tile = (int)L / ksplit, ks = (int)L % ksplit; ksel = ks;
            pm = tile % nM; pn = tile / nM;
            kbyte = ks * (J.K / ksplit) * 2;
        } else {
            int wgid = (int)L;
            { const int q = nwg / 8, r = nwg % 8, xcd = wgid % 8, off = wgid / 8; wgid = (xcd < r ? xcd * (q + 1) : r * (q + 1) + (xcd - r) * q) + off; }
            const int nig = 8 * nN, gid = wgid / nig, fm = gid * 8, gsz = (nM - fm) < 8 ? (nM - fm) : 8;
            pm = fm + ((wgid % nig) % gsz); pn = (wgid % nig) / gsz;
        }
        const int brow = pm * BM, bcol = pn * BM;
        f32x4 acc[2][2][4][2];
#pragma unroll
        for (int a = 0; a < 2; ++a)
#pragma unroll
            for (int b = 0; b < 2; ++b)
#pragma unroll
                for (int m = 0; m < 4; ++m)
#pragma unroll
                    for (int n = 0; n < 2; ++n) acc[a][b][m][n] = (f32x4){0.f, 0.f, 0.f, 0.f};
        bf16x8 At[4][2], B0[2][2], B1[2][2];
        WAIT_V(0);
        STAGE(SB(0, 0), Bt, offB, ldb, bcol, 0); STAGE(SA(0, 0), A, offA, lda, brow, 0);
        STAGE(SB(0, 1), Bt, offB, ldb, bcol + HALF, 0); STAGE(SA(0, 1), A, offA, lda, brow + HALF, 0);
        if (wr == 1) BAR;
        WAIT_V(4); BAR;
        STAGE(SB(1, 0), Bt, offB, ldb, bcol, 1); STAGE(SA(1, 0), A, offA, lda, brow, 1); STAGE(SB(1, 1), Bt, offB, ldb, bcol + HALF, 1);
        WAIT_V(6); BAR;
        for (int t = 0; t < nt - 2; t += 2) {
            LDB(B0, 0, 0); SCHED; LDA(At, 0, 0); STAGE(SA(1, 1), A, offA, lda, brow + HALF, t + 1);
            WAIT_L(8); BAR; WAIT_L(0); MMA(0, 0, At, B0); BAR; SCHED;
            LDB(B1, 0, 1); STAGE(SB(0, 0), Bt, offB, ldb, bcol, t + 2);
            BAR; WAIT_L(0); MMA(0, 1, At, B1); BAR;
            LDA(At, 0, 1); STAGE(SA(0, 0), A, offA, lda, brow, t + 2);
            BAR; WAIT_L(0); MMA(1, 0, At, B0); BAR; SCHED;
            STAGE(SB(0, 1), Bt, offB, ldb, bcol + HALF, t + 2);
            WAIT_V(6); BAR; MMA(1, 1, At, B1); BAR;
            LDB(B0, 1, 0); SCHED; LDA(At, 1, 0); STAGE(SA(0, 1), A, offA, lda, brow + HALF, t + 2);
            WAIT_L(8); BAR; WAIT_L(0); MMA(0, 0, At, B0); BAR; SCHED;
            LDB(B1, 1, 1); STAGE(SB(1, 0), Bt, offB, ldb, bcol, t + 3);
            BAR; WAIT_L(0); MMA(0, 1, At, B1); BAR;
            LDA(At, 1, 1); STAGE(SA(1, 0), A, offA, lda, brow, t + 3);
            BAR; WAIT_L(0); MMA(1, 0, At, B0); BAR; SCHED;
            STAGE(SB(1, 1), Bt, offB, ldb, bcol + HALF, t + 3);
            WAIT_V(6); BAR; MMA(1, 1, At, B1); BAR;
        }
        { LDB(B0, 0, 0); LDA(At, 0, 0); STAGE(SA(1, 1), A, offA, lda, brow + HALF, nt - 1);
          BAR; WAIT_L(0); MMA(0, 0, At, B0); BAR;
          LDB(B1, 0, 1); BAR; WAIT_L(0); MMA(0, 1, At, B1); BAR;
          LDA(At, 0, 1); WAIT_V(4); BAR; WAIT_L(0); MMA(1, 0, At, B0); MMA(1, 1, At, B1); BAR; }
        { LDB(B0, 1, 0); LDA(At, 1, 0); WAIT_V(2); BAR; WAIT_L(0); MMA(0, 0, At, B0); BAR;
          LDB(B1, 1, 1); WAIT_V(0); BAR; WAIT_L(0); MMA(0, 1, At, B1); BAR;
          LDA(At, 1, 1); BAR; WAIT_L(0); MMA(1, 0, At, B0); MMA(1, 1, At, B1); BAR; }
        if (wr == 0) BAR;
        { const int tid2 = fresh_tid(tid_in);
          const int wid2 = tid2 >> 6, lane2 = tid2 & 63;
          gemm_epilogue(J, acc, brow + J.row0, bcol, wid2 >> 2, wid2 & 3, lane2 & 15, lane2 >> 4, ksel); }
    }
#undef SA
#undef SB
}

struct AttnArgs {
    const bf16_t* q; int q_ts, q_hs, q_rot, q_plain;
    const bf16_t* k; int k_ts, k_hs;
    const bf16_t* vt; bf16_t* ao;
    int NH; int ctx_units; float scale;
    const float* sink; const float* rpb; const float* lamp; const float* ng; float lam_init;
};

DI int crow(int i, int h) { return (i & 3) + 8 * (i >> 2) + 4 * h; }

template <int DQK, int DV, int MODE, bool PAIR>
DI void attn_phase(const AttnArgs& a, char* lds, const int tid) {
    constexpr int KW = PAIR ? 128 : DQK;
    constexpr int KST = KW * 2 + 16;
    constexpr int VST = 136;
    constexpr int KBYTES = 64 * KST, VBYTES = DV * VST, BUF = KBYTES + VBYTES;
    constexpr int QB = PAIR ? 128 : 256;
    constexpr int NQB = 4096 / QB;
    constexpr int NS = DQK / 16, NDB = DV / 32;
    constexpr int KCH = (64 * KW * 2 / 16) / NTHREADS;
    constexpr int VCH = (DV * 128 / 16) / NTHREADS;
    constexpr int NOPE = DQK - 64;
    static_assert(2 * BUF <= 120 * 1024, "lds");
    const int wave = tid >> 6, lane = tid & 63, r = lane & 31, h = lane >> 5;
    const int x32 = (lane ^ 32) << 2;
    const int wq = PAIR ? (wave & 3) : wave, gsel = PAIR ? (wave >> 2) : 0;
    const int koff = gsel * 64;
    const float cs = a.scale * LOG2E;
    float* rpbL = (float*)(lds + 122880);
    const int n_lat = 4 * a.NH * NQB;
    const int n_units = n_lat + (a.ctx_units ? 4 * a.NH : 0);
    float lam = 0.f;
    if (PAIR) {
        float p0 = a.lamp[lane] * a.lamp[64 + lane], p1 = a.lamp[128 + lane] * a.lamp[192 + lane];
        p0 = wave_sum(p0, lane); p1 = wave_sum(p1, lane);
        lam = __expf(p0) - __expf(p1) + a.lam_init;
    }
    for (int u = blockIdx.x; u < n_units; u += gridDim.x) {
        const bool isctx = u >= n_lat;
        int b, hh, qb;
        if (!isctx) { qb = u % NQB; hh = (u / NQB) % a.NH; b = u / (NQB * a.NH); }
        else { const int v = u - n_lat; qb = 0; hh = v % a.NH; b = v / a.NH; }
        const int tokq0 = isctx ? (NLAT + b * 256) : (b * 4096 + qb * QB);
        const int tokq = tokq0 + wq * 32 + r;
        const int qhead = PAIR ? 2 * hh + gsel : hh;
        const int kvhead = (MODE == 1) ? (hh >> 2) : hh;
        const bf16_t* qp = a.q + (size_t)tokq * a.q_ts + qhead * a.q_hs;
        const bf16_t* kbase = a.k + kvhead * a.k_hs;
        const bf16_t* vbase = a.vt + (size_t)(kvhead * DV) * MT;
        int tlo = 0, thi = 0;
        if (!isctx) {
            if (MODE == 0) { tlo = 0; thi = 64; }
            else if (MODE == 1) { const int q0 = qb * QB; tlo = (q0 - 128) < 0 ? 0 : (q0 - 128) >> 6; thi = (q0 + QB + 128) >> 6; if (thi > 64) thi = 64; }
            else { const int r0 = qb * 4; int lo = r0 - 4; lo = lo < 0 ? 0 : (lo > 56 ? 56 : lo); int hi2 = r0 + 3 - 4; hi2 = hi2 < 0 ? 0 : (hi2 > 56 ? 56 : hi2); tlo = lo; thi = hi2 + 8; }
        }
        const int T = 4 + (thi - tlo);
        if (MODE == 2) {
            for (int i = tid; i < 465; i += NTHREADS) rpbL[i] = a.rpb[hh * 465 + i];
        }
        const int qpos = qb * QB + wq * 32 + r;
        const int qrow = qpos >> 6, qcol = qpos & 63;
        int cstart = qcol - 8; cstart = cstart < 0 ? 0 : (cstart > 48 ? 48 : cstart);
        int rstart = qrow - 4; rstart = rstart < 0 ? 0 : (rstart > 56 ? 56 : rstart);

        constexpr bool D2 = (KCH + VCH) <= 4;
        constexpr int NSET = D2 ? 2 : 1;
        u32x4 kreg[NSET][KCH], vreg[NSET][VCH];
        const __amdgpu_buffer_rsrc_t rs_k = __builtin_amdgcn_make_buffer_rsrc((void*)kbase, 0, 0x7fffffff, 0x00020000);
        const __amdgpu_buffer_rsrc_t rs_v = __builtin_amdgcn_make_buffer_rsrc((void*)vbase, 0, 0x7fffffff, 0x00020000);
        auto tile_tok = [&](int t) { return t < 4 ? (NLAT + b * 256 + t * 64) : (b * 4096 + (tlo + t - 4) * 64); };
        auto load_tile = [&](int t, const int set) __attribute__((always_inline)) {
            const int tok = tile_tok(t);
#pragma unroll
            for (int c = 0; c < KCH; ++c) { const int idx = tid + c * NTHREADS, row = idx / (KW / 8), ch = idx % (KW / 8);
                kreg[set][c] = __builtin_amdgcn_raw_buffer_load_b128(rs_k, (row * a.k_ts + ch * 8) * 2, tok * a.k_ts * 2, 0); }
#pragma unroll
            for (int c = 0; c < VCH; ++c) { const int idx = tid + c * NTHREADS, row = idx >> 3, ch = idx & 7;
                vreg[set][c] = __builtin_amdgcn_raw_buffer_load_b128(rs_v, (row * MT + ch * 8) * 2, tok * 2, 0); }
        };
        auto store_tile = [&](int buf, const int set) __attribute__((always_inline)) {
            char* kb = lds + buf * BUF; char* vb = kb + KBYTES;
#pragma unroll
            for (int c = 0; c < KCH; ++c) { const int idx = tid + c * NTHREADS, row = idx / (KW / 8), ch = idx % (KW / 8);
                *(u32x4*)(kb + row * KST + ch * 16) = kreg[set][c]; }
#pragma unroll
            for (int c = 0; c < VCH; ++c) { const int idx = tid + c * NTHREADS, row = idx >> 3, ch = idx & 7;
                u32x2 w0 = {vreg[set][c].x, vreg[set][c].y}, w1 = {vreg[set][c].z, vreg[set][c].w};
                *(u32x2*)(vb + row * VST + ch * 16) = w0; *(u32x2*)(vb + row * VST + ch * 16 + 8) = w1; }
        };
        constexpr int NQ = (DQK == 64) ? 2 : 1;
        bf16x8 qf[NQ][NS];
        auto load_q = [&](bool lat, const int slot) __attribute__((always_inline)) {
#pragma unroll
            for (int s = 0; s < NS; ++s) {
                const int off = (s * 16 < NOPE) ? s * 16 : ((lat ? a.q_rot : a.q_plain) + s * 16 - NOPE);
                qf[slot][s] = *(const bf16x8*)(qp + off + 8 * h);
            }
        };
        f32x16 ot[NDB];
#pragma unroll
        for (int d = 0; d < NDB; ++d)
#pragma unroll
            for (int i = 0; i < 16; ++i) ot[d][i] = 0.f;
        float m_run = -1e30f, l_run = 0.f;

        load_tile(0, 0); store_tile(0, 0);
        if (D2) load_tile(T > 1 ? 1 : 0, 1);
        load_q(false, 0);
        if (NQ == 2) load_q(true, NQ - 1);
        __syncthreads();
        auto tile_body = [&](const int t, const bool LAT, const int PAR) __attribute__((always_inline)) {
            if (D2) load_tile(t + 2 < T ? t + 2 : T - 1, PAR);
            else load_tile(t + 1 < T ? t + 1 : T - 1, 0);
            const char* kb_l = lds + (t & 1) * BUF; const char* vb_l = kb_l + KBYTES;
            bool skip = false;
            const int kt = tlo + t - 4;
            if (LAT) {
                if (MODE == 1) { const int ts = kt * 64, qw = qb * QB + wq * 32; skip = (ts + 63 < qw - 128) || (ts > qw + 31 + 128); }
                if (MODE == 2) { skip = (kt < rstart) || (kt >= rstart + 8); }
            }
            if (!skip) {
              if constexpr (DQK == 64) {
                constexpr int G = (NS <= 4) ? NS : 6;
                constexpr bool VBOTH = (DV == 64);
                f32x16 st[2];
#pragma unroll
                for (int i = 0; i < 16; ++i) { st[0][i] = 0.f; st[1][i] = 0.f; }
#pragma unroll
                for (int g0 = 0; g0 < NS; g0 += G) {
                    bf16x8 ka[G], kc[G];
#pragma unroll
                    for (int s = 0; s < G; ++s) {
                        ka[s] = *(const bf16x8*)(kb_l + r * KST + (koff + 8 * h) * 2 + (g0 + s) * 32);
                        kc[s] = *(const bf16x8*)(kb_l + (32 + r) * KST + (koff + 8 * h) * 2 + (g0 + s) * 32);
                    }
                    __builtin_amdgcn_sched_barrier(0);
#pragma unroll
                    for (int s = 0; s < G; ++s) {
                        st[0] = __builtin_amdgcn_mfma_f32_32x32x16_bf16(ka[s], qf[LAT ? NQ - 1 : 0][g0 + s], st[0], 0, 0, 0);
                        st[1] = __builtin_amdgcn_mfma_f32_32x32x16_bf16(kc[s], qf[LAT ? NQ - 1 : 0][g0 + s], st[1], 0, 0, 0);
                    }
                }
                s16x4 vlo[VBOTH ? 2 : 1][2][NDB], vhi[VBOTH ? 2 : 1][2][NDB];
#pragma unroll
                for (int kb = 0; kb < (VBOTH ? 2 : 1); ++kb)
#pragma unroll
                    for (int s2 = 0; s2 < 2; ++s2)
#pragma unroll
                        for (int d = 0; d < NDB; ++d) {
                            const char* vp = vb_l + (32 * d + r) * VST + (32 * kb + 16 * s2 + 4 * h) * 2;
                            vlo[kb][s2][d] = *(const s16x4*)vp; vhi[kb][s2][d] = *(const s16x4*)(vp + 16);
                        }
                __builtin_amdgcn_sched_barrier(0);
                const bool MASKED = (MODE != 0) && LAT;
                float mx = -3e38f;
                if (MASKED) {
#pragma unroll
                    for (int kb = 0; kb < 2; ++kb)
#pragma unroll
                        for (int i = 0; i < 16; ++i) {
                            float tv = st[kb][i] * cs;
                            if (MODE == 1) {
                                const int d = kt * 64 + 32 * kb + crow(i, h) - qpos; const bool valid = (d <= 128) && (d >= -128); tv = valid ? tv : -1e30f;
                            } else if (MODE == 2) {
                                const int kc2 = 32 * kb + crow(i, h);
                                const bool valid = (kc2 >= cstart) && (kc2 < cstart + 16);
                                int bi = (kt - qrow + 7) * 31 + (kc2 - qcol + 15); bi = valid ? bi : 0;
                                const float bias = rpbL[bi];
                                tv = valid ? (tv + bias * LOG2E) : -1e30f;
                            }
                            st[kb][i] = tv; mx = fmaxf(mx, tv);
                        }
                } else {
#pragma unroll
                    for (int kb = 0; kb < 2; ++kb)
#pragma unroll
                        for (int i = 0; i < 16; ++i) mx = fmaxf(mx, st[kb][i]);
                    mx *= cs;
                }
                mx = max_x32(mx);
                if (__any(mx - m_run > RESCALE_THR)) {
                    const float m_up = fmaxf(m_run, mx);
                    const float alpha = fexp2(m_run - m_up);
                    l_run *= alpha;
#pragma unroll
                    for (int d = 0; d < NDB; ++d)
#pragma unroll
                        for (int i = 0; i < 16; ++i) ot[d][i] *= alpha;
                    m_run = m_up;
                }
                const float m_new = m_run;
                float rs = 0.f;
#pragma unroll
                for (int kb = 0; kb < 2; ++kb)
#pragma unroll
                    for (int i = 0; i < 16; ++i) {
                        const float p = MASKED ? fexp2(st[kb][i] - m_new) : fexp2(__builtin_fmaf(st[kb][i], cs, -m_new));
                        st[kb][i] = p; rs += p;
                    }
                l_run += rs;
#pragma unroll
                for (int kb = 0; kb < 2; ++kb) {
                    if (!VBOTH && kb == 1) {
#pragma unroll
                        for (int s2 = 0; s2 < 2; ++s2)
#pragma unroll
                            for (int d = 0; d < NDB; ++d) {
                                const char* vp = vb_l + (32 * d + r) * VST + (32 + 16 * s2 + 4 * h) * 2;
                                vlo[0][s2][d] = *(const s16x4*)vp; vhi[0][s2][d] = *(const s16x4*)(vp + 16);
                            }
                    }
                    const int vs = VBOTH ? kb : 0;
#pragma unroll
                    for (int s2 = 0; s2 < 2; ++s2) {
                        u32x4 pw;
                        pw.x = pack2(st[kb][8 * s2 + 0], st[kb][8 * s2 + 1]); pw.y = pack2(st[kb][8 * s2 + 2], st[kb][8 * s2 + 3]);
                        pw.z = pack2(st[kb][8 * s2 + 4], st[kb][8 * s2 + 5]); pw.w = pack2(st[kb][8 * s2 + 6], st[kb][8 * s2 + 7]);
                        const bf16x8 pf = __builtin_bit_cast(bf16x8, pw);
#pragma unroll
                        for (int d = 0; d < NDB; ++d) {
                            const bf16x8 vf = __builtin_shufflevector(vlo[vs][s2][d], vhi[vs][s2][d], 0, 1, 2, 3, 4, 5, 6, 7);
                            ot[d] = __builtin_amdgcn_mfma_f32_32x32x16_bf16(vf, pf, ot[d], 0, 0, 0);
                        }
                    }
                }
              } else {
                constexpr bool PREK = NS <= 4;
                bf16x8 kf[NS];
#pragma unroll
                for (int s = 0; s < NS; ++s) kf[s] = *(const bf16x8*)(kb_l + r * KST + (koff + 8 * h) * 2 + s * 32);
#pragma unroll
                for (int kb = 0; kb < 2; ++kb) {
                    f32x16 st;
#pragma unroll
                    for (int i = 0; i < 16; ++i) st[i] = 0.f;
                    __builtin_amdgcn_sched_barrier(0);
#pragma unroll
                    for (int s = 0; s < NS; ++s) st = __builtin_amdgcn_mfma_f32_32x32x16_bf16(kf[s], qf[0][s], st, 0, 0, 0);
                    s16x4 vlo[2][NDB], vhi[2][NDB];
#pragma unroll
                    for (int s2 = 0; s2 < 2; ++s2)
#pragma unroll
                        for (int d = 0; d < NDB; ++d) {
                            const char* vp = vb_l + (32 * d + r) * VST + (32 * kb + 16 * s2 + 4 * h) * 2;
                            vlo[s2][d] = *(const s16x4*)vp; vhi[s2][d] = *(const s16x4*)(vp + 16);
                        }
                    if (kb == 0) {
                        if (PREK) {
#pragma unroll
                            for (int s = 0; s < NS; ++s) kf[s] = *(const bf16x8*)(kb_l + (32 + r) * KST + (koff + 8 * h) * 2 + s * 32);
                        }
                    }
                    __builtin_amdgcn_sched_barrier(0);
                    const bool MASKED = (MODE != 0) && LAT;
                    float mx = -3e38f;
                    if (MASKED) {
#pragma unroll
                        for (int i = 0; i < 16; ++i) {
                            float tv = st[i] * cs;
                            if (MODE == 1) {
                                const int d = kt * 64 + 32 * kb + crow(i, h) - qpos; const bool valid = (d <= 128) && (d >= -128); tv = valid ? tv : -1e30f;
                            } else if (MODE == 2) {
                                const int kc = 32 * kb + crow(i, h);
                                const bool valid = (kc >= cstart) && (kc < cstart + 16);
                                int bi = (kt - qrow + 7) * 31 + (kc - qcol + 15); bi = valid ? bi : 0;
                                const float bias = rpbL[bi];
                                tv = valid ? (tv + bias * LOG2E) : -1e30f;
                            }
                            st[i] = tv; mx = fmaxf(mx, tv);
                        }
                    } else {
#pragma unroll
                        for (int i = 0; i < 16; ++i) mx = fmaxf(mx, st[i]);
                        mx *= cs;
                    }
                    mx = max_x32(mx);
                    if (__any(mx - m_run > RESCALE_THR)) {
                        const float m_up = fmaxf(m_run, mx);
                        const float alpha = fexp2(m_run - m_up);
                        l_run *= alpha;
#pragma unroll
                        for (int d = 0; d < NDB; ++d)
#pragma unroll
                            for (int i = 0; i < 16; ++i) ot[d][i] *= alpha;
                        m_run = m_up;
                    }
                    const float m_new = m_run;
                    float rs = 0.f;
                    if (MASKED) {
#pragma unroll
                        for (int i = 0; i < 16; ++i) { const float p = fexp2(st[i] - m_new); st[i] = p; rs += p; }
                    } else {
#pragma unroll
                        for (int i = 0; i < 16; ++i) { const float p = fexp2(__builtin_fmaf(st[i], cs, -m_new)); st[i] = p; rs += p; }
                    }
                    l_run += rs;
#pragma unroll
                    for (int s2 = 0; s2 < 2; ++s2) {
                        u32x4 pw;
                        pw.x = pack2(st[8 * s2 + 0], st[8 * s2 + 1]); pw.y = pack2(st[8 * s2 + 2], st[8 * s2 + 3]);
                        pw.z = pack2(st[8 * s2 + 4], st[8 * s2 + 5]); pw.w = pack2(st[8 * s2 + 6], st[8 * s2 + 7]);
                        const bf16x8 pf = __builtin_bit_cast(bf16x8, pw);
#pragma unroll
                        for (int d = 0; d < NDB; ++d) {
                            const bf16x8 vf = __builtin_shufflevector(vlo[s2][d], vhi[s2][d], 0, 1, 2, 3, 4, 5, 6, 7);
                            ot[d] = __builtin_amdgcn_mfma_f32_32x32x16_bf16(vf, pf, ot[d], 0, 0, 0);
                        }
                    }
                    if (kb == 0) {
                        if (!PREK) {
#pragma unroll
                            for (int s = 0; s < NS; ++s) kf[s] = *(const bf16x8*)(kb_l + (32 + r) * KST + (koff + 8 * h) * 2 + s * 32);
                        }
                    }
                }
              }
            }
            store_tile((t + 1) & 1, D2 ? (PAR ^ 1) : 0);
            asm volatile("s_waitcnt lgkmcnt(0)" ::: "memory"); __builtin_amdgcn_s_barrier(); asm volatile("" ::: "memory");
        };
        for (int t = 0; t < 4; t += 2) { tile_body(t, false, 0); tile_body(t + 1, false, 1); }
        if (T > 4) {
            if (NQ == 1) load_q(true, 0);
            for (int t = 4; t < T; t += 2) { tile_body(t, true, 0); if (t + 1 < T) tile_body(t + 1, true, 1); }
        }
        float l_tot = l_run + bperm(l_run, x32);
        if (MODE == 1) l_tot += fexp2(a.sink[hh] * LOG2E - m_run);
        const float inv = 1.0f / l_tot;
        if (!PAIR) {
            bf16_t* op = a.ao + (size_t)tokq * 1024 + hh * DV;
#pragma unroll
            for (int d = 0; d < NDB; ++d)
#pragma unroll
                for (int g = 0; g < 4; ++g) {
                    f32x4 v = {ot[d][4 * g] * inv, ot[d][4 * g + 1] * inv, ot[d][4 * g + 2] * inv, ot[d][4 * g + 3] * inv};
                    *(u32x2*)(op + 32 * d + 8 * g + 4 * h) = pack4(v);
                }
        } else {
            float* ex = (float*)lds;
            if (gsel == 1) {
#pragma unroll
                for (int d = 0; d < NDB; ++d)
#pragma unroll
                    for (int i = 0; i < 16; ++i) ex[(wq * 128 + 32 * d + crow(i, h)) * 32 + r] = ot[d][i] * inv;
            }
            __syncthreads();
            if (gsel == 0) {
                float ss = 0.f;
#pragma unroll
                for (int d = 0; d < NDB; ++d)
#pragma unroll
                    for (int i = 0; i < 16; ++i) {
                        const float o1 = ex[(wq * 128 + 32 * d + crow(i, h)) * 32 + r];
                        const float v = ot[d][i] * inv - lam * o1;
                        ot[d][i] = v; ss += v * v;
                    }
                ss += bperm(ss, x32);
                const float rstd = rsqrtf(ss * (1.0f / 128.0f) + EPSV) * (1.0f - a.lam_init);
                bf16_t* op = a.ao + (size_t)tokq * 1024 + hh * DV;
#pragma unroll
                for (int d = 0; d < NDB; ++d)
#pragma unroll
                    for (int g = 0; g < 4; ++g) {
                        const int dd = 32 * d + 8 * g + 4 * h;
                        f32x4 gn = *(const f32x4*)(a.ng + dd);
                        f32x4 v = {ot[d][4 * g] * rstd * gn[0], ot[d][4 * g + 1] * rstd * gn[1], ot[d][4 * g + 2] * rstd * gn[2], ot[d][4 * g + 3] * rstd * gn[3]};
                        *(u32x2*)(op + dd) = pack4(v);
                    }
            }
            __syncthreads();
        }
    }
}

DI void norm_phase(float* X, const float* g, const float* mods_l, int shift_i, int scale_i, bf16_t* H, int nrows, const int tid, const float* part, int npart) {
    const int wave = tid >> 6, lane = tid & 63;
    const int gw = blockIdx.x * 8 + wave, nw = gridDim.x * 8;
    for (int row = gw; row < nrows; row += nw) {
        float* xp = X + (size_t)row * DM;
        f32x4 v[4]; float ss = 0.f;
#pragma unroll
        for (int i = 0; i < 4; ++i) v[i] = *(const f32x4*)(xp + i * 256 + lane * 4);
        if (row >= NLAT && npart > 0) {
            for (int sidx = 0; sidx < npart; ++sidx) {
                const float* pp = part + ((size_t)sidx * (MT - NLAT) + (row - NLAT)) * DM;
#pragma unroll
                for (int i = 0; i < 4; ++i) v[i] += *(const f32x4*)(pp + i * 256 + lane * 4);
            }
#pragma unroll
            for (int i = 0; i < 4; ++i) *(f32x4*)(xp + i * 256 + lane * 4) = v[i];
        }
#pragma unroll
        for (int i = 0; i < 4; ++i) ss += v[i][0] * v[i][0] + v[i][1] * v[i][1] + v[i][2] * v[i][2] + v[i][3] * v[i][3];
        ss = wave_sum(ss, lane);
        const float rstd = rsqrtf(ss * (1.0f / 1024.0f) + EPSV);
        const float* mp = mods_l + (size_t)mod_row(row) * 9216;
#pragma unroll
        for (int i = 0; i < 4; ++i) {
            const int col = i * 256 + lane * 4;
            f32x4 gg = *(const f32x4*)(g + col), sh = *(const f32x4*)(mp + shift_i * 1024 + col), sc = *(const f32x4*)(mp + scale_i * 1024 + col);
            f32x4 y = (v[i] * rstd) * gg;
            y = y * (sc + 1.0f) + sh;
            *(u32x2*)(H + (size_t)row * DM + col) = pack4(y);
        }
    }
}

DI void final_phase(const float* X, const float* g, float* out, const int tid) {
    const int wave = tid >> 6, lane = tid & 63;
    const int gw = blockIdx.x * 8 + wave, nw = gridDim.x * 8;
    for (int row = gw; row < NLAT; row += nw) {
        const float* xp = X + (size_t)row * DM;
        f32x4 v[4]; float ss = 0.f;
#pragma unroll
        for (int i = 0; i < 4; ++i) { v[i] = *(const f32x4*)(xp + i * 256 + lane * 4); ss += v[i][0] * v[i][0] + v[i][1] * v[i][1] + v[i][2] * v[i][2] + v[i][3] * v[i][3]; }
        ss = wave_sum(ss, lane);
        const float rstd = rsqrtf(ss * (1.0f / 1024.0f) + EPSV);
#pragma unroll
        for (int i = 0; i < 4; ++i) {
            const int col = i * 256 + lane * 4;
            f32x4 gg = *(const f32x4*)(g + col);
            *(f32x4*)(out + (size_t)row * DM + col) = (v[i] * rstd) * gg;
        }
    }
}

struct ConvJob { const float* src; int srcN, K, dstN, mode, coloff; const float* scale; size_t dst; };

DI int rope_dim(int w, int grp) { return (w < 16) ? grp * 16 + w : 32 + grp * 16 + (w - 16); }
DI int conv_perm(int mode, int coloff, int n) {
    switch (mode) {
    case 0: return coloff + n;
    case 1: { const int t = n >> 8, q = n & 255, bj = q >> 7, wcc = (q & 127) >> 5, nn = (q & 31) >> 4, i = q & 15;
              return (bj ? 2816 : 0) + t * 128 + wcc * 32 + (i >> 2) * 8 + nn * 4 + (i & 3); }
    case 2: { const int blk = n >> 6, grp = (n >> 5) & 1, w = n & 31; return coloff + blk * 64 + rope_dim(w, grp); }
    case 3: { if (n < 768) return n; if (n >= 832) return -1; const int rr = n - 768; return 768 + rope_dim(rr & 31, rr >> 5); }
    case 4: { const int g = n >> 5, head = g / 6, gi = g - head * 6, w = n & 31; if (gi < 4) return head * 192 + gi * 32 + w; return head * 192 + 128 + rope_dim(w, gi - 4); }
    case 5: return (n >> 7) * 256 + (n & 127);
    default: return (n >> 7) * 256 + 128 + (n & 127);
    }
}

DI ConvJob get_conv_job(const Params& p, int j) {
    ConvJob c; c.scale = nullptr; c.coloff = 0; c.mode = 0; c.K = 1024; c.srcN = 1024; c.dstN = 1024;
    if (j < 8) { c.src = p.in[8] + (size_t)j * 1024 * 5632; c.srcN = 5632; c.dstN = 5632; c.mode = 1; c.dst = W_IN + (size_t)j * 5632 * 1024; }
    else if (j < 16) { c.src = p.in[9] + (size_t)(j - 8) * 2816 * 1024; c.K = 2816; c.dst = W_OUT + (size_t)(j - 8) * 1024 * 2816; }
    else switch (j) {
    case 16: c.src = p.in[10]; c.srcN = 832; c.mode = 3; c.dst = W_MLA_DOWN; break;
    case 17: c.src = p.in[13]; c.srcN = 1536; c.K = 512; c.dstN = 1536; c.mode = 4; c.scale = p.in[11]; c.dst = W_MLA_UQ; break;
    case 18: c.src = p.in[14]; c.srcN = 2048; c.K = 256; c.mode = 5; c.scale = p.in[12]; c.dst = W_MLA_UK; break;
    case 19: c.src = p.in[14]; c.srcN = 2048; c.K = 256; c.mode = 6; c.scale = p.in[12]; c.dst = W_MLA_UV; break;
    case 20: c.src = p.in[15]; c.dst = W_MLA_WO; break;
    case 21: c.src = p.in[16]; c.srcN = 1536; c.dstN = 1280; c.mode = 2; c.dst = W_SWA_QK; break;
    case 22: c.src = p.in[16]; c.srcN = 1536; c.dstN = 256; c.coloff = 1280; c.dst = W_SWA_V; break;
    case 23: c.src = p.in[18]; c.dst = W_SWA_WO; break;
    case 24: c.src = p.in[19]; c.srcN = 3072; c.dstN = 2048; c.dst = W_NA_QK; break;
    case 25: c.src = p.in[19]; c.srcN = 3072; c.coloff = 2048; c.dst = W_NA_V; break;
    case 26: c.src = p.in[21]; c.dst = W_NA_WO; break;
    case 27: c.src = p.in[22]; c.srcN = 3072; c.dstN = 2048; c.mode = 2; c.dst = W_DIFF_QK; break;
    case 28: c.src = p.in[22]; c.srcN = 3072; c.coloff = 2048; c.dst = W_DIFF_V; break;
    default: c.src = p.in[25]; c.dst = W_DIFF_WO; break;
    }
    return c;
}
constexpr int N_CONV = 30;

DI void prep_phase(const Params& p, char* lds, const int tid) {
    bf16_t* W = (bf16_t*)(p.ws + OFF_W);
    {
        constexpr int TST = 528;
        int rot = 0;
        for (int j = 0; j < N_CONV; ++j) {
            const ConvJob c = get_conv_job(p, j);
            const int nkt = c.K / 256, units = (c.dstN / 64) * nkt;
            int first = (int)blockIdx.x - rot; if (first < 0) first += gridDim.x;
            for (int u = first; u < units; u += gridDim.x) {
                const int ntile = u / nkt, kt = u % nkt;
                const int nl = tid & 63, kk = tid >> 6;
                const int sc = conv_perm(c.mode, c.coloff, ntile * 64 + nl);
                const int k0 = kt * 256 + kk * 32;
                float v[32];
#pragma unroll
                for (int i = 0; i < 32; ++i) v[i] = (sc >= 0) ? c.src[(size_t)(k0 + i) * c.srcN + sc] : 0.f;
                if (c.scale) {
#pragma unroll
                    for (int i = 0; i < 32; ++i) v[i] *= c.scale[k0 + i];
                }
#pragma unroll
                for (int i = 0; i < 16; ++i) *(unsigned*)(lds + nl * TST + (kk * 32 + 2 * i) * 2) = pack2(v[2 * i], v[2 * i + 1]);
                __syncthreads();
#pragma unroll
                for (int i = 0; i < 4; ++i) {
                    const int idx = tid + i * NTHREADS, n = idx >> 5, ch = idx & 31;
                    u32x4 w = *(const u32x4*)(lds + n * TST + ch * 16);
                    *(u32x4*)(W + c.dst + (size_t)(ntile * 64 + n) * c.K + kt * 256 + ch * 8) = w;
                }
                __syncthreads();
            }
            rot = (rot + units) % (int)gridDim.x;
        }
    }
    {
        float* sc = (float*)lds;
        float* red = (float*)(lds + 20480);
        for (int i = tid; i < 5 * 1024; i += NTHREADS) {
            const int rr = i >> 10, k = i & 1023;
            const float cv = rr < 4 ? p.in[1][rr * 1024 + k] : p.in[3][k];
            sc[i] = siluf(cv);
        }
        __syncthreads();
        float* mods = (float*)(p.ws + OFF_MODS);
        const int c4 = tid & 31, ks = tid >> 5;
        for (int u = blockIdx.x; u < 4 * 72; u += gridDim.x) {
            const int l = u / 72, n0 = (u % 72) * 128;
            const float* wp = p.in[4] + (size_t)l * 1024 * 9216 + n0 + c4 * 4;
            f32x4 a0 = {0, 0, 0, 0}, a1 = a0, a2 = a0, a3 = a0, a4 = a0;
#pragma unroll 8
            for (int kk = 0; kk < 64; ++kk) {
                const int k = ks * 64 + kk;
                const f32x4 w = *(const f32x4*)(wp + (size_t)k * 9216);
                a0 += w * sc[k]; a1 += w * sc[1024 + k]; a2 += w * sc[2048 + k]; a3 += w * sc[3072 + k]; a4 += w * sc[4096 + k];
            }
            *(f32x4*)(red + (ks * 5 + 0) * 128 + c4 * 4) = a0; *(f32x4*)(red + (ks * 5 + 1) * 128 + c4 * 4) = a1;
            *(f32x4*)(red + (ks * 5 + 2) * 128 + c4 * 4) = a2; *(f32x4*)(red + (ks * 5 + 3) * 128 + c4 * 4) = a3;
            *(f32x4*)(red + (ks * 5 + 4) * 128 + c4 * 4) = a4;
            __syncthreads();
            for (int i = tid; i < 5 * 128; i += NTHREADS) {
                const int rr = i >> 7, cc = i & 127;
                float s = p.in[5][l * 9216 + n0 + cc];
#pragma unroll
                for (int q = 0; q < 16; ++q) s += red[(q * 5 + rr) * 128 + cc];
                mods[((size_t)l * 5 + rr) * 9216 + n0 + cc] = s;
            }
            __syncthreads();
        }
    }
    {
        float* cosT = (float*)(p.ws + OFF_COS); float* sinT = (float*)(p.ws + OFF_SIN);
        for (int i = blockIdx.x * NTHREADS + tid; i < 4096 * 32; i += gridDim.x * NTHREADS) {
            const int pos = i >> 5, d = i & 31, f = d & 15;
            const float inv = expf(-9.210340371976184f * (float)f / 16.0f);
            const float base = (d < 16) ? (float)(pos >> 6) : (float)(pos & 63);
            const float ang = base * inv;
            float rev = ang * 0.15915494309189535f; rev = rev - floorf(rev);
            cosT[i] = __builtin_amdgcn_cosf(rev); sinT[i] = __builtin_amdgcn_sinf(rev);
        }
    }
    {
        f32x4* X4 = (f32x4*)(p.ws + OFF_X);
        const f32x4* x4 = (const f32x4*)p.in[0]; const f32x4* c4p = (const f32x4*)p.in[2];
        const size_t nlat4 = (size_t)NLAT * 256, nall4 = (size_t)MT * 256;
        for (size_t i = (size_t)blockIdx.x * NTHREADS + tid; i < nall4; i += (size_t)gridDim.x * NTHREADS)
            X4[i] = i < nlat4 ? x4[i] : c4p[i - nlat4];
    }
}

constexpr int N_PHASES = 1 + 4 * 11 + 1;
__host__ __device__ inline bool phase_is_noop(int ph) {
    if (ph == 0 || ph == N_PHASES - 1) return false;
    const int layer = (ph - 1) / 11, slot = (ph - 1) % 11;
    return slot == 5 && layer != 0;
}

DI GemmJob get_job(const Params& p, int layer, int slot, int jidx, int& nj, const bool dry) {
    char* ws = p.ws;
    bf16_t* W = (bf16_t*)(ws + OFF_W);
    float* X = (float*)(ws + OFF_X);
    bf16_t* H = (bf16_t*)(ws + OFF_H);
    bf16_t* R = (bf16_t*)(ws + OFF_R);
    bf16_t* RQ = (bf16_t*)(ws + OFF_R + R_Q); bf16_t* RK = (bf16_t*)(ws + OFF_R + R_K);
    bf16_t* RVT = (bf16_t*)(ws + OFF_R + R_VT); bf16_t* RD = (bf16_t*)(ws + OFF_R + R_DRAW);
    const float* mods_l = (const float*)(ws + OFF_MODS) + (size_t)layer * 5 * 9216;
    float* stats = (float*)(ws + OFF_STATS);
    const float* cosT = (const float*)(ws + OFF_COS); const float* sinT = (const float*)(ws + OFF_SIN);
    const bool last = layer == 3;
    GemmJob j; j.o0 = j.o1 = nullptr; j.o2 = nullptr; j.f0 = j.f1 = nullptr; j.i0 = 0; j.s0 = 0.f; j.ksplit = 1; j.row0 = 0;
    if (slot == 1 || slot == 9) {
        const int f = slot == 1 ? 0 : 1;
        j.A = H; j.lda = 1024; j.B = W + W_IN + (size_t)(layer * 2 + f) * 5632 * 1024; j.ldb = 1024;
        j.M = (last && f == 1) ? NLAT : MT; j.N = 5632; j.K = 1024; j.epi = EPI_SWIGLU; j.o0 = R;
        nj = 1; return j;
    }
    if (slot == 2 || slot == 10) {
        const int f = slot == 2 ? 0 : 1;
        j.A = R; j.lda = DFF; j.B = W + W_OUT + (size_t)(layer * 2 + f) * 1024 * 2816; j.ldb = DFF;
        j.M = NLAT; j.N = 1024; j.K = DFF; j.epi = EPI_RESID; j.o0 = X;
        j.f0 = mods_l + (f == 0 ? 2 : 8) * 1024; j.s0 = 0.5f;
        nj = (last && f == 1) ? 1 : 2;
        if (dry) { nj = 1; j.s0 = 0.f; }
        if (jidx == 1) { j.A = R + (size_t)NLAT * DFF; j.M = MT - NLAT; j.row0 = NLAT; j.ksplit = 11; j.epi = EPI_RESID_ATOMIC; j.o2 = (float*)(ws + OFF_R + R_VT); }
        return j;
    }
    if (slot == 7) {
        const size_t wo = layer == 0 ? W_MLA_WO : layer == 1 ? W_SWA_WO : layer == 2 ? W_NA_WO : W_DIFF_WO;
        j.A = H; j.lda = 1024; j.B = W + wo; j.ldb = 1024; j.M = NLAT; j.N = 1024; j.K = 1024;
        j.epi = EPI_RESID; j.o0 = X; j.f0 = mods_l + 5 * 1024; j.s0 = 1.0f;
        nj = last ? 1 : 2;
        if (dry) { nj = 1; j.s0 = 0.f; }
        if (jidx == 1) { j.A = H + (size_t)NLAT * 1024; j.M = MT - NLAT; j.row0 = NLAT; j.ksplit = 4; j.epi = EPI_RESID_ATOMIC; j.o2 = (float*)(ws + OFF_R + R_DRAW); }
        return j;
    }
    if (slot == 4) {
        if (layer == 0) {
            j.A = H; j.lda = 1024; j.B = W + W_MLA_DOWN; j.ldb = 1024; j.M = MT; j.N = 1024; j.K = 1024;
            j.epi = EPI_MLA_DOWN; j.o0 = RD; j.o1 = RK; j.o2 = stats; j.f0 = cosT; j.f1 = sinT;
            nj = 1; return j;
        }
        j.A = H; j.lda = 1024; j.ldb = 1024; j.M = MT; j.K = 1024; j.o0 = RQ; j.o1 = RK;
        if (layer == 1) { j.B = W + W_SWA_QK; j.N = 1280; j.epi = EPI_ROPE; j.i0 = 16; j.f0 = cosT; j.f1 = sinT; }
        else if (layer == 2) { j.B = W + W_NA_QK; j.N = 2048; j.epi = EPI_PLAIN2; }
        else { j.B = W + W_DIFF_QK; j.N = 2048; j.epi = EPI_ROPE; j.i0 = 16; j.f0 = cosT; j.f1 = sinT; }
        nj = 2;
        if (jidx == 0) return j;
        GemmJob v; v.o1 = nullptr; v.o2 = nullptr; v.f0 = v.f1 = nullptr; v.i0 = 0; v.s0 = 0.f; v.ksplit = 1; v.row0 = 0;
        v.A = W + (layer == 1 ? W_SWA_V : layer == 2 ? W_NA_V : W_DIFF_V); v.lda = 1024; v.B = H; v.ldb = 1024;
        v.M = layer == 1 ? 256 : 1024; v.N = MT; v.K = 1024; v.epi = EPI_VT; v.o0 = RVT;
        return v;
    }
    j.A = RD; j.lda = 1024; j.B = W + W_MLA_UQ; j.ldb = 512; j.M = MT; j.N = 1536; j.K = 512;
    j.epi = EPI_MLA_Q; j.o0 = RQ; j.o1 = (void*)cosT; j.f0 = stats; j.f1 = sinT;
    nj = 3;
    if (jidx == 0) return j;
    GemmJob k = j; k.A = RD + 512; k.B = W + W_MLA_UK; k.ldb = 256; k.N = 1024; k.K = 256; k.epi = EPI_MLA_K; k.o0 = RK; k.o1 = nullptr; k.f1 = nullptr;
    if (jidx == 1) return k;
    GemmJob v = k; v.A = W + W_MLA_UV; v.lda = 256; v.B = RD + 512; v.ldb = 1024; v.M = 1024; v.N = MT; v.epi = EPI_VT; v.o0 = RVT; v.i0 = 1;
    return v;
}

DI void run_phase(const Params& p, int ph, char* lds, const int wave_s, const bool dry = false) {
    char* ws = p.ws;
    float* X = (float*)(ws + OFF_X);
    bf16_t* H = (bf16_t*)(ws + OFF_H);
#ifndef NO_PREP
    if (ph == 0) { prep_phase(p, lds, fresh_tid(wave_s)); return; }
#endif
    if (ph == N_PHASES - 1) { final_phase(X, p.in[7], p.out, fresh_tid(wave_s)); return; }
    const int layer = (ph - 1) / 11, slot = (ph - 1) % 11;
    const float* mods_l = (const float*)(ws + OFF_MODS) + (size_t)layer * 5 * 9216;
    const bool last = layer == 3;
    if (slot == 0 || slot == 3 || slot == 8) {
        const int sub = slot == 0 ? 0 : slot == 3 ? 1 : 2;
        const float* part = (sub == 2) ? (const float*)(ws + OFF_R + R_DRAW) : (const float*)(ws + OFF_R + R_VT);
        const int npart = (sub == 2) ? 4 : ((sub == 0 && layer == 0) ? 0 : 11);
        norm_phase(X, p.in[6] + (size_t)(layer * 3 + sub) * 1024, mods_l, sub * 3, sub * 3 + 1, H, (last && sub == 2) ? NLAT : MT, fresh_tid(wave_s), part, (last && sub == 2) ? 0 : npart);
        return;
    }
#ifndef NO_ATTN
    if (slot == 6) {
        const int tid = fresh_tid(wave_s);
        AttnArgs a;
        a.q = (const bf16_t*)(ws + OFF_R + R_Q); a.k = (const bf16_t*)(ws + OFF_R + R_K); a.vt = (const bf16_t*)(ws + OFF_R + R_VT);
        a.ao = H; a.sink = nullptr; a.rpb = nullptr; a.lamp = nullptr; a.ng = nullptr; a.lam_init = 0.f; a.ctx_units = last ? 0 : 1;
        if (layer == 0) {
            a.q_ts = 2048; a.q_hs = 256; a.q_rot = 128; a.q_plain = 192; a.k_ts = 1536; a.k_hs = 192; a.NH = 8; a.scale = 0.07216878364870322f;
            attn_phase<192, 128, 0, false>(a, lds, tid);
        } else if (layer == 1) {
            a.q_ts = 2048; a.q_hs = 128; a.q_rot = 0; a.q_plain = 64; a.k_ts = 256; a.k_hs = 64; a.NH = 16; a.scale = 0.125f; a.sink = p.in[17];
            attn_phase<64, 64, 1, false>(a, lds, tid);
        } else if (layer == 2) {
            a.q_ts = 1024; a.q_hs = 64; a.q_rot = 0; a.q_plain = 0; a.k_ts = 1024; a.k_hs = 64; a.NH = 16; a.scale = 0.125f; a.rpb = p.in[20];
            attn_phase<64, 64, 2, false>(a, lds, tid);
        } else {
            a.q_ts = 2048; a.q_hs = 128; a.q_rot = 0; a.q_plain = 64; a.k_ts = 1024; a.k_hs = 128; a.NH = 8; a.scale = 0.125f;
            a.lamp = p.in[23]; a.ng = p.in[24]; a.lam_init = 0.5560582f;
            attn_phase<64, 128, 0, true>(a, lds, tid);
        }
        return;
    }
#endif
#ifndef NO_GEMM
    int nj = 1, rot = 0;
#pragma unroll 1
    for (int j = 0; j < nj; ++j) {
        const GemmJob job = get_job(p, layer, slot, j, nj, dry);
        gemm_run(job, lds, wave_s, rot);
        rot = (rot + (job.M / BM) * (job.N / BM) * job.ksplit) % (int)gridDim.x;
    }
#endif
}

__global__ void __launch_bounds__(NTHREADS) mega_kernel(Params p, int ph_lo, int ph_hi) {
    extern __shared__ __attribute__((aligned(16))) char lds[];
    cg::grid_group grid = cg::this_grid();
    const int wave_s = __builtin_amdgcn_readfirstlane(threadIdx.x >> 6);
    if (ph_lo > ph_hi) grid.sync();
    XcdBarrier xb; xb.bar = (unsigned*)(p.ws + OFF_BAR); xb.x = xb_xcc_id(); xb.st = (volatile LAS unsigned*)&lds[131072];
    if (ph_hi - ph_lo > 1) {
        const bool t0 = fresh_tid(wave_s) == 0;
        if (t0) { xb.st[0] = 0u; xb.st[1] = 0u; }
        __syncthreads();
        if (t0) (void)xb_add(&xb.bar[XB_XCNT(xb.x)], 1u);
    }
#pragma unroll 1
    for (int ph = ph_lo; ph < ph_hi; ++ph) {
        if (phase_is_noop(ph)) continue;
        run_phase(p, ph, lds, wave_s);
        if (PROBE_DUP) {
            const int slot_ = (ph >= 1 && ph < N_PHASES - 1) ? (ph - 1) % 11 : -1;
            bool dup = false;
            if (PROBE_DUP == 1) dup = ph == 0;
            if (PROBE_DUP == 3) dup = slot_ == 6;
            if (PROBE_DUP >= 30 && PROBE_DUP < 34) dup = slot_ == 6 && (ph - 1) / 11 == PROBE_DUP - 30;
            if (PROBE_DUP == 4) dup = slot_ == 0 || slot_ == 3 || slot_ == 8;
            if (PROBE_DUP == 5) dup = slot_ == 1 || slot_ == 9;
            if (PROBE_DUP == 6) dup = slot_ == 4 || slot_ == 5;
            if (PROBE_DUP == 7) dup = slot_ == 2 || slot_ == 10;
            if (PROBE_DUP == 8) dup = slot_ == 7;
            if (PROBE_DUP == 2) xcd_barrier(xb, fresh_tid(wave_s) == 0);
            if (dup) { xcd_barrier(xb, fresh_tid(wave_s) == 0); run_phase(p, ph, lds, wave_s, PROBE_DUP >= 7); }
        }
        if (ph + 1 < ph_hi) xcd_barrier(xb, fresh_tid(wave_s) == 0);
    }
}

extern "C" void kernel_launch(void* const* d_in, const int* in_sizes, int n_in, void* d_out, int out_size, void* d_ws, size_t ws_size,
                              hipStream_t stream) {
    static int grid_blocks = 0;
    if (!grid_blocks) {
        (void)hipFuncSetAttribute((const void*)mega_kernel, hipFuncAttributeMaxDynamicSharedMemorySize, LDS_BYTES);
        int dev = 0, cus = 0, per_cu = 0;
        (void)hipGetDevice(&dev);
        (void)hipDeviceGetAttribute(&cus, hipDeviceAttributeMultiprocessorCount, dev);
        (void)hipOccupancyMaxActiveBlocksPerMultiprocessor(&per_cu, mega_kernel, NTHREADS, LDS_BYTES);
        if (per_cu < 1) per_cu = 1;
        if (per_cu > 1) per_cu = 1;
        grid_blocks = cus * per_cu;
        grid_blocks -= grid_blocks % 8;
        if (ws_size < WS_NEED) fprintf(stderr, "workspace too small: %zu < %zu\n", ws_size, (size_t)WS_NEED);
    }
    Params p{};
    for (int i = 0; i < 26; ++i) p.in[i] = (const float*)d_in[i];
    p.out = (float*)d_out; p.ws = (char*)d_ws;
#if MK_SINGLE
    (void)hipMemsetAsync((char*)d_ws + OFF_BAR, 0, 16384, stream);
    int lo = 0, hi = N_PHASES;
    void* args[] = {&p, &lo, &hi};
    hipError_t e = hipLaunchCooperativeKernel((const void*)mega_kernel, dim3(grid_blocks), dim3(NTHREADS), args, LDS_BYTES, stream);
    if (e != hipSuccess) fprintf(stderr, "cooperative launch failed: %s (grid %d)\n", hipGetErrorString(e), grid_blocks);
#else
    for (int ph = 0; ph < N_PHASES; ++ph) {
        if (phase_is_noop(ph)) continue;
        mega_kernel<<<dim3(grid_blocks), dim3(NTHREADS), LDS_BYTES, stream>>>(p, ph, ph + 1);
    }
#endif
}
```
